# Optimizing an MI355X kernel written in HIP

```python
import math
import jax, jax.numpy as jnp
from jax import lax
import numpy as np

D_MODEL = 1024
BATCH = 4
SEQ = 4096
DEPTH = 4

GRID_W = 64
CTX_LEN = 256
MIX_WIDTH = D_MODEL
S5_WIDTH = MIX_WIDTH // 2
S5_GROUP = 16
S5_GROUPS = S5_WIDTH // S5_GROUP
S5_STATE = 64
HG_WIDTH = MIX_WIDTH - S5_WIDTH
HG_HEAD_DIM = 128
HG_HEADS = HG_WIDTH // HG_HEAD_DIM
HG_CHUNK = 32
D_FF = 11 * D_MODEL // 4
CONV_W = 3
DT_MIN = 1e-3
DT_MAX = 1e-1
ALPHA = (2 * DEPTH) ** 0.25
BETA = (8 * DEPTH) ** -0.25
LN_EPS = 1e-5
RMS_EPS = 1e-6
U_END = S5_WIDTH
FF_END = U_END + HG_WIDTH
FB_END = FF_END + HG_WIDTH
I_END = FB_END + HG_WIDTH
Q_END = I_END + HG_WIDTH
IN_COLS = Q_END + HG_WIDTH

kernel_name = "hybrid_s5_hgrn2_deepnorm_dit"


def layer_norm(x, g, b):
    xf = x.astype(jnp.float32)
    mu = jnp.mean(xf, axis=-1, keepdims=True)
    var = jnp.mean(jnp.square(xf - mu), axis=-1, keepdims=True)
    return ((xf - mu) * lax.rsqrt(var + LN_EPS) * g + b).astype(x.dtype)


def rms_norm(x, g):
    xf = x.astype(jnp.float32)
    return xf * lax.rsqrt(jnp.mean(jnp.square(xf), axis=-1, keepdims=True) + RMS_EPS) * g


def modulate(h, shift, scale):
    return h * (1 + scale) + shift


def cmul(ar, ai, br, bi):
    return ar * br - ai * bi, ar * bi + ai * br


def s5_discretise(lam_re, lam_im, log_dt, b_re, b_im):
    f32 = jnp.float32
    lr, li = lam_re.astype(f32), lam_im.astype(f32)
    dt = jnp.exp(log_dt.astype(f32))[:, None]
    mag, ang = jnp.exp(lr * dt), li * dt
    abar_re, abar_im = mag * jnp.cos(ang), mag * jnp.sin(ang)
    den = lr * lr + li * li
    nr, ni = abar_re - 1.0, abar_im
    coef_re = (nr * lr + ni * li) / den
    coef_im = (ni * lr - nr * li) / den
    bbar_re, bbar_im = cmul(coef_re[..., None], coef_im[..., None], b_re.astype(f32), b_im.astype(f32))
    return abar_re, abar_im, bbar_re, bbar_im


def ssm_combine(e1, e2):
    a1r, a1i, b1r, b1i = e1
    a2r, a2i, b2r, b2i = e2
    ar, ai = cmul(a2r, a2i, a1r, a1i)
    br, bi = cmul(a2r, a2i, b1r, b1i)
    return ar, ai, br + b2r, bi + b2i


def s5_scan(u, abar_re, abar_im, bbar_re, bbar_im, s0):
    bu_re = jnp.einsum('bngh,gph->bngp', u, bbar_re)
    bu_im = jnp.einsum('bngh,gph->bngp', u, bbar_im)
    if s0 is not None:
        init_re, init_im = cmul(abar_re, abar_im, s0[0], s0[1])
        bu_re = bu_re.at[:, 0].add(init_re)
        bu_im = bu_im.at[:, 0].add(init_im)
    a_re = jnp.broadcast_to(abar_re, bu_re.shape)
    a_im = jnp.broadcast_to(abar_im, bu_im.shape)
    _, _, x_re, x_im = lax.associative_scan(ssm_combine, (a_re, a_im, bu_re, bu_im), axis=1)
    return x_re, x_im


def gla_direction(k, v, logf, s0, q):
    bsz, n = k.shape[:2]
    nc = n // HG_CHUNK
    chunk = lambda t: t.reshape(bsz, nc, HG_CHUNK, HG_HEADS, HG_HEAD_DIM)
    k, v, logf = chunk(k), chunk(v), chunk(logf)
    bcum = jnp.cumsum(logf, axis=2)
    bend = bcum[:, :, -1:]
    kd = k * jnp.exp(bend - bcum)
    ds = jnp.einsum('bcshk,bcshv->cbhkv', kd, v)
    dec = jnp.exp(bend[:, :, 0]).transpose(1, 0, 2, 3)
    want_out = q is not None

    def step(s, inp):
        dec_c, ds_c = inp
        return dec_c[..., None] * s + ds_c, (s if want_out else None)

    s_fin, s_start = lax.scan(step, s0, (dec, ds))
    if not want_out:
        return None, s_fin
    q = chunk(q)
    o_inter = jnp.einsum('bclhk,cbhkv->bclhv', q * jnp.exp(bcum), s_start)
    att = jnp.einsum('bclhk,bcshk->bchls', q * jnp.exp(bcum - bend), kd)
    tril = jnp.tril(jnp.ones((HG_CHUNK, HG_CHUNK), dtype=bool))
    att = jnp.where(tril, att, 0.0)
    o_intra = jnp.einsum('bchls,bcshv->bclhv', att, v)
    return (o_inter + o_intra).reshape(bsz, n, HG_HEADS, HG_HEAD_DIM), s_fin


def token_mixer(h, w_in, s5p, hgp, init, with_out, with_states):
    lam_re, lam_im, log_dt, b_re, b_im, c_re, c_im, d_skip, w_glu, b_glu = s5p
    lb, norm_w = hgp
    bsz, n = h.shape[:2]
    cols = IN_COLS if with_out else I_END
    proj = (h @ w_in[:, :cols]).astype(jnp.float32)
    u = proj[..., :U_END]
    f_raws = (proj[..., U_END:FF_END], proj[..., FF_END:FB_END])
    heads = lambda t: t.reshape(bsz, n, HG_HEADS, HG_HEAD_DIM)
    v = heads(proj[..., FB_END:I_END])
    q = heads(jax.nn.silu(proj[..., I_END:Q_END])) if with_out else None

    ug = u.reshape(bsz, n, S5_GROUPS, S5_GROUP)
    s5_ys, s5_fin, hg_os, hg_fin = [], [], [], []
    for dr in range(2):
        flip = (lambda t: t[:, ::-1]) if dr == 1 else (lambda t: t)
        abar_re, abar_im, bbar_re, bbar_im = s5_discretise(lam_re[dr], lam_im[dr], log_dt[dr], b_re[dr], b_im[dr])
        x_re, x_im = s5_scan(flip(ug), abar_re, abar_im, bbar_re, bbar_im, None if init is None else init[0][dr])
        if with_states:
            s5_fin.append((x_re[:, -1], x_im[:, -1]))
        if with_out:
            y = jnp.einsum('bngp,ghp->bngh', x_re, c_re[dr]) - jnp.einsum('bngp,ghp->bngh', x_im, c_im[dr])
            s5_ys.append(flip(y).reshape(bsz, n, S5_WIDTH))
        f = lb[dr] + (1.0 - lb[dr]) * jax.nn.sigmoid(f_raws[dr])
        s0 = jnp.zeros((bsz, HG_HEADS, HG_HEAD_DIM, HG_HEAD_DIM), jnp.float32) if init is None else init[1][dr]
        o, s_fin = gla_direction(flip(heads(1.0 - f)), flip(v), flip(heads(jnp.log(f))), s0,
                                 flip(q) if with_out else None)
        if with_states:
            hg_fin.append(s_fin)
        if with_out:
            hg_os.append(flip(o))
    states = (s5_fin, hg_fin) if with_states else None
    if not with_out:
        return None, states
    s5_y = jax.nn.gelu(s5_ys[0] + s5_ys[1] + u * d_skip)
    s5_out = s5_y * jax.nn.sigmoid(s5_y @ w_glu + b_glu)
    hg_out = rms_norm(hg_os[0] + hg_os[1], norm_w).reshape(bsz, n, HG_WIDTH) * jax.nn.silu(proj[..., Q_END:IN_COLS])
    return jnp.concatenate([s5_out, hg_out], axis=-1), states


def dwconv(u, w, b):
    m = u.shape[-2]
    pad = CONV_W // 2
    up = jnp.pad(u, [(0, 0)] * (u.ndim - 2) + [(pad, pad), (0, 0)])
    out = up[..., 0:m, :] * w[0]
    for j in range(1, CONV_W):
        out = out + up[..., j:j + m, :] * w[j]
    return out + b


def conv_ffn(h, w_up, conv_w, conv_b, w_down, on_grid):
    bsz, n = h.shape[:2]
    up = h @ w_up
    if on_grid:
        rows = n // GRID_W
        up = up.reshape(bsz, rows, GRID_W, 2 * D_FF)
    up = dwconv(up, conv_w, conv_b).reshape(bsz, n, 2 * D_FF)
    a, g = jnp.split(up, 2, axis=-1)
    return (jax.nn.silu(a) * g) @ w_down


def setup_inputs(seed: int = 0) -> dict:
    key = jax.random.key(seed)
    ks = jax.random.split(key, 32)
    f32 = jnp.float32
    L, G, P, H = DEPTH, S5_GROUPS, S5_STATE, S5_GROUP
    nrm = lambda i, shape, scale: scale * jax.random.normal(ks[i], shape, f32)
    return {
        "x": nrm(0, (BATCH, SEQ, D_MODEL), 1.0),
        "c": nrm(1, (BATCH, D_MODEL), 1.0),
        "ctx": nrm(2, (BATCH, CTX_LEN, D_MODEL), 1.0),
        "c_ctx": nrm(3, (D_MODEL,), 1.0),
        "w_mod": nrm(4, (L, D_MODEL, 6 * D_MODEL), 0.5 * D_MODEL ** -0.5),
        "b_mod": nrm(5, (L, 6 * D_MODEL), 0.01),
        "w_in": nrm(6, (L, D_MODEL, IN_COLS), D_MODEL ** -0.5),
        "s5_lam_re": -0.5 + nrm(7, (L, 2, G, P), 0.01),
        "s5_lam_im": jnp.pi * jnp.arange(P, dtype=f32) + nrm(8, (L, 2, G, P), 0.01),
        "s5_log_dt": jax.random.uniform(ks[9], (L, 2, G), f32, math.log(DT_MIN), math.log(DT_MAX)),
        "s5_b_re": nrm(10, (L, 2, G, P, H), (2 * H) ** -0.5),
        "s5_b_im": nrm(11, (L, 2, G, P, H), (2 * H) ** -0.5),
        "s5_c_re": nrm(12, (L, 2, G, H, P), P ** -0.5),
        "s5_c_im": nrm(13, (L, 2, G, H, P), P ** -0.5),
        "s5_d": nrm(14, (L, S5_WIDTH), 1.0),
        "w_glu": nrm(15, (L, S5_WIDTH, S5_WIDTH), S5_WIDTH ** -0.5),
        "b_glu": nrm(16, (L, S5_WIDTH), 0.01),
        "hg_lb": nrm(17, (L, 2, HG_WIDTH), 0.1),
        "hg_norm_w": 1.0 + nrm(18, (L, HG_HEAD_DIM), 0.01),
        "w_out": nrm(19, (L, MIX_WIDTH, D_MODEL), BETA * MIX_WIDTH ** -0.5),
        "ln1_g": 1.0 + nrm(20, (L, D_MODEL), 0.01),
        "ln1_b": nrm(21, (L, D_MODEL), 0.01),
        "w_up": nrm(22, (L, D_MODEL, 2 * D_FF), D_MODEL ** -0.5),
        "conv_w": nrm(23, (L, CONV_W, 2 * D_FF), CONV_W ** -0.5),
        "conv_b": nrm(24, (L, 2 * D_FF), 0.01),
        "w_down": nrm(25, (L, D_FF, D_MODEL), BETA * D_FF ** -0.5),
        "ln2_g": 1.0 + nrm(26, (L, D_MODEL), 0.01),
        "ln2_b": nrm(27, (L, D_MODEL), 0.01),
    }


def reference(x, c, ctx, c_ctx, w_mod, b_mod, w_in, s5_lam_re, s5_lam_im, s5_log_dt, s5_b_re, s5_b_im,
              s5_c_re, s5_c_im, s5_d, w_glu, b_glu, hg_lb, hg_norm_w, w_out, ln1_g, ln1_b,
              w_up, conv_w, conv_b, w_down, ln2_g, ln2_b):
    lb_all = jnp.cumsum(jax.nn.softmax(hg_lb.astype(jnp.float32), axis=0), axis=0)
    lb_all = lb_all - lb_all[:1]
    silu_c = jax.nn.silu(c)
    silu_cc = jax.nn.silu(c_ctx)
    for l in range(DEPTH):
        last = l == DEPTH - 1
        mod_x = (silu_c @ w_mod[l] + b_mod[l])[:, None, :]
        sh1, sc1, g1, sh2, sc2, g2 = jnp.split(mod_x, 6, axis=-1)
        mc = jnp.split(silu_cc @ w_mod[l] + b_mod[l], 6, axis=-1)
        s5p = (s5_lam_re[l], s5_lam_im[l], s5_log_dt[l], s5_b_re[l], s5_b_im[l],
               s5_c_re[l], s5_c_im[l], s5_d[l], w_glu[l], b_glu[l])
        hgp = (lb_all[l], hg_norm_w[l])
        y_c, ctx_states = token_mixer(modulate(ctx, mc[0], mc[1]), w_in[l], s5p, hgp, None, not last, True)
        y_x, _ = token_mixer(modulate(x, sh1, sc1), w_in[l], s5p, hgp, ctx_states, True, False)
        x = layer_norm(ALPHA * x + g1 * (y_x @ w_out[l]), ln1_g[l], ln1_b[l])
        x = layer_norm(ALPHA * x + g2 * conv_ffn(modulate(x, sh2, sc2), w_up[l], conv_w[l], conv_b[l], w_down[l], True),
                       ln2_g[l], ln2_b[l])
        if not last:
            ctx = layer_norm(ALPHA * ctx + mc[2] * (y_c @ w_out[l]), ln1_g[l], ln1_b[l])
            ctx = layer_norm(ALPHA * ctx + mc[5] * conv_ffn(modulate(ctx, mc[3], mc[4]), w_up[l], conv_w[l],
                                                             conv_b[l], w_down[l], False),
                             ln2_g[l], ln2_b[l])
    return x
```

```cpp
#include <hip/hip_runtime.h>
#include <cstdio>
#include <cstdint>

constexpr int D = 1024, BATCH = 4, SEQ = 4096, DEPTH = 4, CTX = 256;
constexpr int S5W = 512, S5G = 32, S5H = 16, S5P = 64, HGW = 512, HD = 128, NH = 4;
constexpr int DFF = 2816, INC = 3072;
constexpr int MC = BATCH * CTX;
constexpr int MX = BATCH * SEQ;
constexpr int M = MC + MX;
constexpr float ALPHA = 1.681792830507429f;
constexpr float LN_EPS = 1e-5f, RMS_EPS = 1e-6f;

enum { I_X = 0, I_C, I_CTX, I_CCTX, I_WMOD, I_BMOD, I_WIN, I_LRE, I_LIM, I_LDT, I_BRE, I_BIM, I_CRE, I_CIM, I_SD, I_WGLU, I_BGLU,
       I_HGLB, I_HGNW, I_WOUT, I_LN1G, I_LN1B, I_WUP, I_CONVW, I_CONVB, I_WDOWN, I_LN2G, I_LN2B, N_IN };

__device__ __forceinline__ float sigmoidf_(float x) { return 1.f / (1.f + __expf(-x)); }
__device__ __forceinline__ float siluf_(float x) { return x / (1.f + __expf(-x)); }
__device__ __forceinline__ float gelu_tanh(float x) { const float u = 0.7978845608028654f * (x + 0.044715f * x * x * x); return 0.5f * x * (1.f + tanhf(u)); }
__host__ __device__ __forceinline__ int row_batch(int r) { return r < MC ? r / CTX : (r - MC) / SEQ; }
__host__ __device__ __forceinline__ int row_modidx(int r) { return r < MC ? 4 : (r - MC) / SEQ; }

__global__ void k_mod(const float* c, const float* cctx, const float* wmod, const float* bmod, float* mod) {
    const int idx = blockIdx.x * blockDim.x + threadIdx.x;
    if (idx >= DEPTH * 5 * 6 * D) return;
    const int j = idx % (6 * D), r = (idx / (6 * D)) % 5, l = idx / (6 * D * 5);
    const float* cv = r < 4 ? c + r * D : cctx;
    const float* w = wmod + (size_t)l * D * 6 * D + j;
    float acc = bmod[l * 6 * D + j];
    for (int k = 0; k < D; ++k) acc += siluf_(cv[k]) * w[(size_t)k * 6 * D];
    mod[idx] = acc;
}
__global__ void k_lb(const float* hglb, float* lb) {
    const int idx = blockIdx.x * blockDim.x + threadIdx.x;
    if (idx >= 2 * HGW) return;
    float v[DEPTH], mx = -1e30f;
#pragma unroll
    for (int l = 0; l < DEPTH; ++l) { v[l] = hglb[l * 2 * HGW + idx]; mx = fmaxf(mx, v[l]); }
    float s = 0.f;
#pragma unroll
    for (int l = 0; l < DEPTH; ++l) { v[l] = __expf(v[l] - mx); s += v[l]; }
    float cum = 0.f, first = 0.f;
#pragma unroll
    for (int l = 0; l < DEPTH; ++l) { cum += v[l] / s; if (l == 0) first = cum; lb[l * 2 * HGW + idx] = cum - first; }
}
__global__ void k_s5disc(const float* lre, const float* lim, const float* ldt, const float* bre, const float* bim, float* ab, float* bb) {
    const int idx = blockIdx.x * blockDim.x + threadIdx.x;
    if (idx >= DEPTH * 2 * S5G * S5P) return;
    const int ldg = idx / S5P;
    const float lr = lre[idx], li = lim[idx], dt = expf(ldt[ldg]);
    const float mag = expf(lr * dt), ang = li * dt;
    const float ar = mag * cosf(ang), ai = mag * sinf(ang);
    ab[idx * 2] = ar; ab[idx * 2 + 1] = ai;
    const float den = lr * lr + li * li, nr = ar - 1.f, ni = ai;
    const float cr = (nr * lr + ni * li) / den, ci = (ni * lr - nr * li) / den;
    for (int h = 0; h < S5H; ++h) {
        const float br = bre[(size_t)idx * S5H + h], bi = bim[(size_t)idx * S5H + h];
        bb[((size_t)idx * S5H + h) * 2] = cr * br - ci * bi; bb[((size_t)idx * S5H + h) * 2 + 1] = cr * bi + ci * br;
    }
}
__global__ void k_copy(const float* a, float* b, size_t n) { for (size_t i = (size_t)blockIdx.x * blockDim.x + threadIdx.x; i < n; i += (size_t)gridDim.x * blockDim.x) b[i] = a[i]; }

__device__ __forceinline__ float* xrow_ptr(float* xc, float* xo, int r) { return r < MC ? xc + (size_t)r * D : xo + (size_t)(r - MC) * D; }
__global__ void k_modulate(float* xc, float* xo, const float* modl, int off_sh, int off_sc, float* H) {
    const int r = blockIdx.x; const float* x = xrow_ptr(xc, xo, r); const float* mr = modl + (size_t)row_modidx(r) * 6 * D;
    for (int k = threadIdx.x; k < D; k += blockDim.x) H[(size_t)r * D + k] = x[k] * (1.f + mr[off_sc + k]) + mr[off_sh + k];
}
__global__ void __launch_bounds__(256) k_gemm(const float* A, int lda, const float* W, int ldw, float* C, int ldc, int K, int accum) {
    __shared__ float As[16][68];
    __shared__ float Ws[16][68];
    const int tx = threadIdx.x & 15, ty = threadIdx.x >> 4, m0 = blockIdx.y * 64, n0 = blockIdx.x * 64;
    float acc[4][4];
#pragma unroll
    for (int i = 0; i < 4; ++i)
#pragma unroll
        for (int j = 0; j < 4; ++j) acc[i][j] = 0.f;
    for (int k0 = 0; k0 < K; k0 += 16) {
        { const int r = threadIdx.x >> 2, kq = (threadIdx.x & 3) * 4; const float4 a = *(const float4*)(A + (size_t)(m0 + r) * lda + k0 + kq);
          As[kq + 0][r] = a.x; As[kq + 1][r] = a.y; As[kq + 2][r] = a.z; As[kq + 3][r] = a.w; }
        { const int kr = threadIdx.x >> 4, nq = (threadIdx.x & 15) * 4; const float4 w = *(const float4*)(W + (size_t)(k0 + kr) * ldw + n0 + nq);
          Ws[kr][nq + 0] = w.x; Ws[kr][nq + 1] = w.y; Ws[kr][nq + 2] = w.z; Ws[kr][nq + 3] = w.w; }
        __syncthreads();
#pragma unroll
        for (int kk = 0; kk < 16; ++kk) {
            float a[4], w[4];
#pragma unroll
            for (int i = 0; i < 4; ++i) { a[i] = As[kk][ty * 4 + i]; w[i] = Ws[kk][tx * 4 + i]; }
#pragma unroll
            for (int i = 0; i < 4; ++i)
#pragma unroll
                for (int j = 0; j < 4; ++j) acc[i][j] += a[i] * w[j];
        }
        __syncthreads();
    }
#pragma unroll
    for (int i = 0; i < 4; ++i)
#pragma unroll
        for (int j = 0; j < 4; ++j) { float* p = C + (size_t)(m0 + ty * 4 + i) * ldc + n0 + tx * 4 + j; *p = accum ? *p + acc[i][j] : acc[i][j]; }
}
__device__ __forceinline__ int s5_row(int b, int d, int s) {
    if (s < CTX) { const int t = d ? CTX - 1 - s : s; return b * CTX + t; }
    const int t = d ? SEQ - 1 - (s - CTX) : (s - CTX); return MC + b * SEQ + t;
}
__global__ void __launch_bounds__(64) k_s5(const float* P, const float* abl, const float* bbl, const float* crel, const float* ciml, float* YF, float* YB) {
    const int b = blockIdx.x / (S5G * 2), g = (blockIdx.x / 2) % S5G, d = blockIdx.x & 1, p = threadIdx.x;
    __shared__ float xs[16][128];
    __shared__ float cs[16][128];
    const int dgp = (d * S5G + g) * S5P + p;
    const float ar = abl[dgp * 2], ai = abl[dgp * 2 + 1];
    float br[16], bi[16];
#pragma unroll
    for (int h = 0; h < 16; ++h) { br[h] = bbl[((size_t)dgp * 16 + h) * 2]; bi[h] = bbl[((size_t)dgp * 16 + h) * 2 + 1]; }
    for (int h = 0; h < 16; ++h) { cs[h][p] = crel[((size_t)(d * S5G + g) * S5H + h) * S5P + p]; cs[h][64 + p] = ciml[((size_t)(d * S5G + g) * S5H + h) * S5P + p]; }
    float* Y = d ? YB : YF;
    float xr = 0.f, xi = 0.f;
    const int NT = CTX + SEQ;
    for (int s0 = 0; s0 < NT; s0 += 16) {
#pragma unroll
        for (int i = 0; i < 16; ++i) {
            const int row = s5_row(b, d, s0 + i);
            const float* u = P + (size_t)row * INC + g * 16;
            float sr = 0.f, si = 0.f;
#pragma unroll
            for (int h = 0; h < 16; ++h) { const float uv = u[h]; sr += br[h] * uv; si += bi[h] * uv; }
            const float nr = ar * xr - ai * xi + sr, ni = ar * xi + ai * xr + si;
            xr = nr; xi = ni;
            xs[i][p] = xr; xs[i][64 + p] = xi;
        }
        __syncthreads();
        { const int t = p >> 2, h0 = (p & 3) * 4; const int row = s5_row(b, d, s0 + t);
#pragma unroll
          for (int hh = 0; hh < 4; ++hh) { const int h = h0 + hh; float acc = 0.f;
              for (int q = 0; q < 64; ++q) acc += xs[t][q] * cs[h][q] - xs[t][64 + q] * cs[h][64 + q];
              Y[(size_t)row * S5W + g * 16 + h] = acc; } }
        __syncthreads();
    }
}
__global__ void __launch_bounds__(128) k_gla(const float* P, const float* lbl, float* OF, float* OB) {
    const int b = blockIdx.x / (NH * 2), hd = (blockIdx.x / 2) % NH, d = blockIdx.x & 1, v = threadIdx.x;
    __shared__ float fs[128], ks[128], qs[128];
    float S[128];
#pragma unroll
    for (int k = 0; k < 128; ++k) S[k] = 0.f;
    const float lbv = lbl[d * HGW + hd * HD + v];
    float* O = d ? OB : OF;
    const int NT = CTX + SEQ;
    for (int s = 0; s < NT; ++s) {
        int row;
        if (s < CTX) { const int t = d ? CTX - 1 - s : s; row = b * CTX + t; }
        else { const int t = d ? SEQ - 1 - (s - CTX) : (s - CTX); row = MC + b * SEQ + t; }
        const float* pr = P + (size_t)row * INC;
        const float fr = pr[512 + d * 512 + hd * HD + v];
        const float f = lbv + (1.f - lbv) * sigmoidf_(fr);
        fs[v] = f; ks[v] = 1.f - f; qs[v] = siluf_(pr[2048 + hd * HD + v]);
        const float vv = pr[1536 + hd * HD + v];
        __syncthreads();
        float o = 0.f;
#pragma unroll
        for (int k = 0; k < 128; ++k) { S[k] = fs[k] * S[k] + ks[k] * vv; o += S[k] * qs[k]; }
        O[(size_t)row * HGW + hd * HD + v] = o;
        __syncthreads();
    }
}
__global__ void __launch_bounds__(512) k_mixout(const float* P, float* YF, const float* YB, float* OF, const float* OB, const float* sd, const float* nw) {
    const int r = blockIdx.x, c = threadIdx.x;
    __shared__ float red[8];
    const float* pr = P + (size_t)r * INC;
    const float y = YF[(size_t)r * S5W + c] + YB[(size_t)r * S5W + c] + pr[c] * sd[c];
    YF[(size_t)r * S5W + c] = gelu_tanh(y);
    const float o = OF[(size_t)r * HGW + c] + OB[(size_t)r * HGW + c];
    float s = o * o;
    for (int off = 32; off >= 1; off >>= 1) s += __shfl_xor(s, off);
    if ((c & 63) == 0) red[c >> 6] = s;
    __syncthreads();
    const float ms = (red[(c >> 7) * 2] + red[(c >> 7) * 2 + 1]) * (1.f / 128.f);
    const float g = pr[2560 + c];
    OF[(size_t)r * HGW + c] = o * rsqrtf(ms + RMS_EPS) * nw[c & 127] * siluf_(g);
}
__global__ void k_glu(float* YF, const float* G, const float* bg) {
    const size_t i = (size_t)blockIdx.x * blockDim.x + threadIdx.x; if (i >= (size_t)M * S5W) return;
    const int c = (int)(i % S5W); YF[i] = YF[i] * sigmoidf_(G[i] + bg[c]);
}
__global__ void __launch_bounds__(256) k_resid_ln(float* xc, float* xo, const float* T, const float* modl, int off_gate, const float* lg, const float* lbv, int r0) {
    const int r = r0 + blockIdx.x; float* x = xrow_ptr(xc, xo, r); const float* gate = modl + (size_t)row_modidx(r) * 6 * D + off_gate;
    __shared__ float red[4];
    float z[4]; float s = 0.f;
#pragma unroll
    for (int j = 0; j < 4; ++j) { const int k = threadIdx.x + 256 * j; z[j] = ALPHA * x[k] + gate[k] * T[(size_t)r * D + k]; s += z[j]; }
    for (int off = 32; off >= 1; off >>= 1) s += __shfl_xor(s, off);
    if ((threadIdx.x & 63) == 0) red[threadIdx.x >> 6] = s;
    __syncthreads();
    const float mean = (red[0] + red[1] + red[2] + red[3]) * (1.f / D);
    __syncthreads();
    float q = 0.f;
#pragma unroll
    for (int j = 0; j < 4; ++j) { z[j] -= mean; q += z[j] * z[j]; }
    for (int off = 32; off >= 1; off >>= 1) q += __shfl_xor(q, off);
    if ((threadIdx.x & 63) == 0) red[threadIdx.x >> 6] = q;
    __syncthreads();
    const float rstd = rsqrtf((red[0] + red[1] + red[2] + red[3]) * (1.f / D) + LN_EPS);
#pragma unroll
    for (int j = 0; j < 4; ++j) { const int k = threadIdx.x + 256 * j; x[k] = z[j] * rstd * lg[k] + lbv[k]; }
}
__global__ void k_convgate(const float* UP, float* ACT, const float* cw, const float* cb, int r0, int nrows) {
    const size_t i = (size_t)blockIdx.x * blockDim.x + threadIdx.x; if (i >= (size_t)nrows * DFF) return;
    const int rl = (int)(i / DFF), c = (int)(i % DFF), r = r0 + rl;
    int pos, len; if (r < MC) { pos = r % CTX; len = CTX; } else { pos = (r - MC) % 64; len = 64; }
    float a = cb[c], g = cb[DFF + c];
#pragma unroll
    for (int j = 0; j < 3; ++j) { const int pp = pos + j - 1; if (pp < 0 || pp >= len) continue; const float* u = UP + (size_t)(rl + j - 1) * (2 * DFF);
        a += u[c] * cw[j * 2 * DFF + c]; g += u[DFF + c] * cw[j * 2 * DFF + DFF + c]; }
    ACT[(size_t)rl * DFF + c] = siluf_(a) * g;
}

extern "C" void kernel_launch(void* const* d_in, const int* in_sizes, int n_in, void* d_out, int out_size, void* d_ws, size_t ws_size, hipStream_t stream) {
    const float* in[N_IN]; for (int i = 0; i < N_IN; ++i) in[i] = (const float*)d_in[i];
    float* out = (float*)d_out;
    char* ws = (char*)d_ws; size_t off = 0;
    auto carve = [&](size_t bytes) { float* p = (float*)(ws + off); off += (bytes + 255) & ~(size_t)255; return p; };
    float* MOD = carve((size_t)DEPTH * 5 * 6 * D * 4);
    float* LB = carve((size_t)DEPTH * 2 * HGW * 4);
    float* AB = carve((size_t)DEPTH * 2 * S5G * S5P * 2 * 4);
    float* BB = carve((size_t)DEPTH * 2 * S5G * S5P * S5H * 2 * 4);
    float* XC = carve((size_t)MC * D * 4);
    float* PB = carve((size_t)M * INC * 4);
    float* R1 = carve((size_t)M * D * 4);
    float* R2 = carve((size_t)M * D * 4);
    if (off > ws_size) { fprintf(stderr, "ws too small: need %zu have %zu\n", off, ws_size); return; }
    float* H = R1; float* YF = R1; float* YB = R1 + (size_t)M * S5W; float* OF = R2; float* OB = R2 + (size_t)M * HGW;
    float* T = PB; float* T2 = R2;
    constexpr int RC = M / 4;
    float* UPc = PB; float* ACTc = PB + (size_t)RC * 2 * DFF;

    k_mod<<<(DEPTH * 5 * 6 * D + 255) / 256, 256, 0, stream>>>(in[I_C], in[I_CCTX], in[I_WMOD], in[I_BMOD], MOD);
    k_lb<<<(2 * HGW + 255) / 256, 256, 0, stream>>>(in[I_HGLB], LB);
    k_s5disc<<<(DEPTH * 2 * S5G * S5P + 255) / 256, 256, 0, stream>>>(in[I_LRE], in[I_LIM], in[I_LDT], in[I_BRE], in[I_BIM], AB, BB);
    k_copy<<<2048, 256, 0, stream>>>(in[I_X], out, (size_t)MX * D);
    k_copy<<<512, 256, 0, stream>>>(in[I_CTX], XC, (size_t)MC * D);
    for (int l = 0; l < DEPTH; ++l) {
        const float* modl = MOD + (size_t)l * 5 * 6 * D;
        k_modulate<<<M, 256, 0, stream>>>(XC, out, modl, 0, D, H);
        k_gemm<<<dim3(INC / 64, M / 64), 256, 0, stream>>>(H, D, in[I_WIN] + (size_t)l * D * INC, INC, PB, INC, D, 0);
        k_s5<<<BATCH * S5G * 2, 64, 0, stream>>>(PB, AB + (size_t)l * 2 * S5G * S5P * 2, BB + (size_t)l * 2 * S5G * S5P * S5H * 2,
                                                   in[I_CRE] + (size_t)l * 2 * S5G * S5H * S5P, in[I_CIM] + (size_t)l * 2 * S5G * S5H * S5P, YF, YB);
        k_gla<<<BATCH * NH * 2, 128, 0, stream>>>(PB, LB + (size_t)l * 2 * HGW, OF, OB);
        k_mixout<<<M, 512, 0, stream>>>(PB, YF, YB, OF, OB, in[I_SD] + (size_t)l * S5W, in[I_HGNW] + (size_t)l * HD);
        k_gemm<<<dim3(S5W / 64, M / 64), 256, 0, stream>>>(YF, S5W, in[I_WGLU] + (size_t)l * S5W * S5W, S5W, YB, S5W, S5W, 0);
        k_glu<<<(int)(((size_t)M * S5W + 255) / 256), 256, 0, stream>>>(YF, YB, in[I_BGLU] + (size_t)l * S5W);
        k_gemm<<<dim3(D / 64, M / 64), 256, 0, stream>>>(YF, S5W, in[I_WOUT] + (size_t)l * D * D, D, T, D, S5W, 0);
        k_gemm<<<dim3(D / 64, M / 64), 256, 0, stream>>>(OF, HGW, in[I_WOUT] + (size_t)l * D * D + (size_t)S5W * D, D, T, D, HGW, 1);
        k_resid_ln<<<M, 256, 0, stream>>>(XC, out, T, modl, 2 * D, in[I_LN1G] + (size_t)l * D, in[I_LN1B] + (size_t)l * D, 0);
        k_modulate<<<M, 256, 0, stream>>>(XC, out, modl, 3 * D, 4 * D, H);
        for (int ch = 0; ch < 4; ++ch) {
            const int r0 = ch * RC;
            k_gemm<<<dim3(2 * DFF / 64, RC / 64), 256, 0, stream>>>(H + (size_t)r0 * D, D, in[I_WUP] + (size_t)l * D * 2 * DFF, 2 * DFF, UPc, 2 * DFF, D, 0);
            k_convgate<<<(int)(((size_t)RC * DFF + 255) / 256), 256, 0, stream>>>(UPc, ACTc, in[I_CONVW] + (size_t)l * 3 * 2 * DFF, in[I_CONVB] + (size_t)l * 2 * DFF, r0, RC);
            k_gemm<<<dim3(D / 64, RC / 64), 256, 0, stream>>>(ACTc, DFF, in[I_WDOWN] + (size_t)l * DFF * D, D, T2 + (size_t)r0 * D, D, DFF, 0);
        }
        k_resid_ln<<<M, 256, 0, stream>>>(XC, out, T2, modl, 5 * D, in[I_LN2G] + (size_t)l * D, in[I_LN2B] + (size_t)l * D, 0);
    }
}
```

```cpp
#include <hip/hip_runtime.h>
#include <cstdio>
#include <cstdint>

constexpr int D = 1024, BATCH = 4, SEQ = 4096, DEPTH = 4, CTX = 256;
constexpr int S5W = 512, S5G = 32, S5H = 16, S5P = 64, HGW = 512, HD = 128, NH = 4;
constexpr int DFF = 2816, INC = 3072;
constexpr int MC = BATCH * CTX;
constexpr int MX = BATCH * SEQ;
constexpr int M = MC + MX;
constexpr float ALPHA = 1.681792830507429f;
constexpr float LN_EPS = 1e-5f, RMS_EPS = 1e-6f;

enum { I_X = 0, I_C, I_CTX, I_CCTX, I_WMOD, I_BMOD, I_WIN, I_LRE, I_LIM, I_LDT, I_BRE, I_BIM, I_CRE, I_CIM, I_SD, I_WGLU, I_BGLU,
       I_HGLB, I_HGNW, I_WOUT, I_LN1G, I_LN1B, I_WUP, I_CONVW, I_CONVB, I_WDOWN, I_LN2G, I_LN2B, N_IN };

typedef unsigned short bf16;
__device__ __forceinline__ float sigmoidf_(float x) { return 1.f / (1.f + __expf(-x)); }
__device__ __forceinline__ float siluf_(float x) { return x / (1.f + __expf(-x)); }
__device__ __forceinline__ float gelu_tanh(float x) { const float u = 0.7978845608028654f * (x + 0.044715f * x * x * x); return 0.5f * x * (1.f + tanhf(u)); }
__device__ __forceinline__ float bf2f(bf16 b) { return __uint_as_float(((unsigned)b) << 16); }
__device__ __forceinline__ bf16 f2bf(float f) { unsigned u = __float_as_uint(f); return (bf16)((u + 0x7fffu + ((u >> 16) & 1u)) >> 16); }
__host__ __device__ __forceinline__ int row_modidx(int r) { return r < MC ? 4 : (r - MC) / SEQ; }

namespace pg8 {
#define PG8_LAS __attribute__((address_space(3)))
typedef unsigned short bf16_t;
typedef short bf16x8 __attribute__((ext_vector_type(8)));
typedef float f32x4 __attribute__((ext_vector_type(4)));
typedef unsigned u32x4 __attribute__((ext_vector_type(4)));
constexpr int BM = 256, BK = 64, HALF = 128, HTB = HALF * BK * 2  , STAGE_BYTES = 8 * HTB, NXCD = 8, WGM = 8;

__host__ __device__ __forceinline__ int lds_byte(int r, int c) { const int st = (r >> 4) * 2 + (c >> 5), rr = r & 15, cc = c & 31, ob = rr * 64 + cc * 2; return st * 1024 + (ob ^ (((ob >> 9) & 1) << 5)); }
__host__ __device__ __forceinline__ void stage_rc(int b, int& R, int& C) { const int st = b / 1024, sb = b % 1024, swz = sb ^ (((sb >> 9) & 1) << 5); R = (st >> 1) * 16 + swz / 64; C = (st & 1) * 32 + (swz % 64) / 2; }
__host__ __device__ __forceinline__ int perm32(int rho) { const int n = rho >> 4, i = rho & 15; return 8 * (i >> 2) + 4 * n + (i & 3); }

struct Unit { int pm, pn; };
struct Gemm { const bf16_t* A; const bf16_t* Bt; int M, N, K, pad; };

struct StaticOrder {
    int nM, nN, nwg, G, c;
    __host__ __device__ void init(int M, int N, int G_, int c_) { nM = M / BM; nN = N / BM; nwg = nM * nN; G = G_; c = c_; }
    __host__ __device__ bool next(int i, Unit& u) const {
        const long L = (long)i * G + c; if (L >= nwg) return false;
        int wgid = (int)L; { const int q = nwg / NXCD, r = nwg % NXCD, xcd = wgid % NXCD, off = wgid / NXCD; wgid = (xcd < r ? xcd * (q + 1) : r * (q + 1) + (xcd - r) * q) + off; }
        const int nig = WGM * nN, gid = wgid / nig, fm = gid * WGM, gsz = (nM - fm) < WGM ? (nM - fm) : WGM;
        u.pm = fm + ((wgid % nig) % gsz); u.pn = (wgid % nig) / gsz; return true;
    }
    __device__ __forceinline__ void a_ready(const Unit&) const {}
    __device__ __forceinline__ void done(const Unit&) const {}
};
constexpr int DFF_ = 2816;
__device__ __forceinline__ unsigned cvt_pk_bf16(float lo, float hi) { unsigned r; asm volatile("v_cvt_pk_bf16_f32 %0, %1, %2" : "=v"(r) : "v"(lo), "v"(hi)); return r; }
typedef unsigned u32x2 __attribute__((ext_vector_type(2)));
__device__ __forceinline__ float bflo(unsigned w) { return __uint_as_float(w << 16); }
__device__ __forceinline__ float bfhi(unsigned w) { return __uint_as_float(w & 0xffff0000u); }
__device__ __forceinline__ float sigm(float x) { return __builtin_amdgcn_rcpf(1.f + __expf(-x)); }

struct EpiBf16Plain {
    static constexpr bool PERM = true, AFTER_DRAIN = false;
    bf16_t* O; int ldc, pad;
    __device__ __forceinline__ void operator()(const f32x4 (&acc)[2][2][4][2], const Unit& u, int wr, int wc, int fr, int fq) const {
        const int row0 = u.pm * BM + wr * 64 + fr, col0 = u.pn * BM + wc * 32 + 8 * fq;
#pragma unroll
        for (int ai = 0; ai < 2; ++ai)
#pragma unroll
            for (int m = 0; m < 4; ++m) { bf16_t* rowp = O + (size_t)(row0 + ai * HALF + m * 16) * ldc + col0;
#pragma unroll
                for (int bj = 0; bj < 2; ++bj) { const f32x4 v0 = acc[ai][bj][m][0], v1 = acc[ai][bj][m][1];
                    u32x4 w; w.x = cvt_pk_bf16(v0[0], v0[1]); w.y = cvt_pk_bf16(v0[2], v0[3]); w.z = cvt_pk_bf16(v1[0], v1[1]); w.w = cvt_pk_bf16(v1[2], v1[3]);
                    *(u32x4*)(rowp + bj * HALF) = w; } }
    }
};
struct EpiGlu {
    static constexpr bool PERM = true, AFTER_DRAIN = false;
    bf16_t* Y; const bf16_t* S5Y; const float* bias;
    __device__ __forceinline__ void operator()(const f32x4 (&acc)[2][2][4][2], const Unit& u, int wr, int wc, int fr, int fq) const {
        const int row0 = u.pm * BM + wr * 64 + fr, col0 = u.pn * BM + wc * 32 + 8 * fq;
        f32x4 bv[2][2];
#pragma unroll
        for (int bj = 0; bj < 2; ++bj)
#pragma unroll
            for (int n = 0; n < 2; ++n) bv[bj][n] = *(const f32x4*)(bias + col0 + bj * HALF + 4 * n);
#pragma unroll
        for (int ai = 0; ai < 2; ++ai)
#pragma unroll
            for (int m = 0; m < 4; ++m) { const size_t row = (size_t)(row0 + ai * HALF + m * 16);
#pragma unroll
                for (int bj = 0; bj < 2; ++bj) { const f32x4 v0 = acc[ai][bj][m][0] + bv[bj][0], v1 = acc[ai][bj][m][1] + bv[bj][1];
                    const u32x4 s = *(const u32x4*)(S5Y + row * 512 + col0 + bj * HALF);
                    u32x4 w;
                    w.x = cvt_pk_bf16(bflo(s.x) * sigm(v0[0]), bfhi(s.x) * sigm(v0[1])); w.y = cvt_pk_bf16(bflo(s.y) * sigm(v0[2]), bfhi(s.y) * sigm(v0[3]));
                    w.z = cvt_pk_bf16(bflo(s.z) * sigm(v1[0]), bfhi(s.z) * sigm(v1[1])); w.w = cvt_pk_bf16(bflo(s.w) * sigm(v1[2]), bfhi(s.w) * sigm(v1[3]));
                    *(u32x4*)(Y + row * 1024 + col0 + bj * HALF) = w; } }
    }
};
struct EpiResid {
    static constexpr bool PERM = false, AFTER_DRAIN = false;
    float* XC; float* XO; const float* modl; int off_gate, pad;
    __device__ __forceinline__ void operator()(const f32x4 (&acc)[2][2][4][2], const Unit& u, int wr, int wc, int fr, int fq) const {
        float* xb = u.pm < 4 ? XC + (size_t)u.pm * BM * 1024 : XO + (size_t)(u.pm - 4) * BM * 1024;
        const float* gate = modl + (size_t)(u.pm < 4 ? 4 : (u.pm - 4) >> 4) * 6144 + off_gate;
        const int rl0 = wr * 64 + fr, col0 = u.pn * BM + wc * 32 + 4 * fq;
        f32x4 gv[2][2];
#pragma unroll
        for (int bj = 0; bj < 2; ++bj)
#pragma unroll
            for (int n = 0; n < 2; ++n) gv[bj][n] = *(const f32x4*)(gate + col0 + bj * HALF + n * 16);
#pragma unroll
        for (int ai = 0; ai < 2; ++ai)
#pragma unroll
            for (int m = 0; m < 4; ++m) { float* rowp = xb + (size_t)(rl0 + ai * HALF + m * 16) * 1024 + col0;
#pragma unroll
                for (int bj = 0; bj < 2; ++bj)
#pragma unroll
                    for (int n = 0; n < 2; ++n) { f32x4* p = (f32x4*)(rowp + bj * HALF + n * 16); const f32x4 x = *p; *p = x * 1.681792830507429f + gv[bj][n] * acc[ai][bj][m][n]; } }
    }
};
struct EpiUpConv {
    static constexpr bool PERM = true, AFTER_DRAIN = false;
    bf16_t* ACT; const float* cw; const float* cb; const bf16_t* H; const bf16_t* Wt; PG8_LAS float* halo; int pad;
    __device__ __forceinline__ void operator()(const f32x4 (&acc)[2][2][4][2], const Unit& u, int wr, int wc, int fr, int fq) const {
        const int lane = fq * 16 + fr;
        const bool isctx = u.pm < 4;
        PG8_LAS float* hs = halo + (wr * 4 + wc) * 192;
        if (isctx) {
            const int r0 = wr == 0 ? 64 : 63, r1 = wr == 0 ? 127 : 128, r2 = wr == 0 ? 192 : 191;
            const int hi = lane & 15, hrow = hi == 1 ? r1 : (hi == 2 ? r2 : r0);
            const bf16_t* ap = H + (size_t)(u.pm * BM + hrow) * 1024 + 8 * (lane >> 4);
            const bf16_t* bp = Wt + (size_t)(u.pn * BM + wc * 32 + (lane & 15)) * 1024 + 8 * (lane >> 4);
            f32x4 h4[2][2];
#pragma unroll
            for (int bj = 0; bj < 2; ++bj)
#pragma unroll
                for (int nt = 0; nt < 2; ++nt) h4[bj][nt] = (f32x4){0.f, 0.f, 0.f, 0.f};
#pragma unroll 4
            for (int ks = 0; ks < 32; ++ks) {
                const bf16x8 a = *(const bf16x8*)(ap + 32 * ks);
#pragma unroll
                for (int bj = 0; bj < 2; ++bj)
#pragma unroll
                    for (int nt = 0; nt < 2; ++nt) { const bf16x8 b = *(const bf16x8*)(bp + (size_t)(bj * HALF + nt * 16) * 1024 + 32 * ks);
                        h4[bj][nt] = __builtin_amdgcn_mfma_f32_16x16x32_bf16(a, b, h4[bj][nt], 0, 0, 0); }
            }
            if (lane < 16) {
#pragma unroll
                for (int bj = 0; bj < 2; ++bj)
#pragma unroll
                    for (int nt = 0; nt < 2; ++nt) { hs[(bj * 3 + 0) * 32 + nt * 16 + lane] = h4[bj][nt][0]; hs[(bj * 3 + 1) * 32 + nt * 16 + lane] = h4[bj][nt][1]; hs[(bj * 3 + 2) * 32 + nt * 16 + lane] = h4[bj][nt][2]; }
            }
            asm volatile("s_waitcnt lgkmcnt(0)" ::: "memory");
        }
        const int lprev = (lane & 48) | ((lane - 1) & 15), lnext = (lane & 48) | ((lane + 1) & 15);
        const int row0 = u.pm * BM + wr * 64 + fr, ocol = u.pn * HALF + wc * 32 + 8 * fq;
#pragma unroll
        for (int n = 0; n < 2; ++n) {
            f32x4 w0[2], w1[2], w2[2], bb[2];
#pragma unroll
            for (int bj = 0; bj < 2; ++bj) { const int oc = bj * DFF_ + ocol + 4 * n;
                w0[bj] = *(const f32x4*)(cw + oc); w1[bj] = *(const f32x4*)(cw + 2 * DFF_ + oc); w2[bj] = *(const f32x4*)(cw + 4 * DFF_ + oc); bb[bj] = *(const f32x4*)(cb + oc); }
#pragma unroll
            for (int ai = 0; ai < 2; ++ai) {
                const int ip = wr == 0 ? (ai == 0 ? -1 : 1) : (ai == 0 ? 0 : 2);
                const int in = wr == 0 ? (ai == 0 ? 0 : 2) : (ai == 0 ? 1 : -1);
                f32x4 hp[2], hn[2];
#pragma unroll
                for (int bj = 0; bj < 2; ++bj) { hp[bj] = (f32x4){0.f, 0.f, 0.f, 0.f}; hn[bj] = (f32x4){0.f, 0.f, 0.f, 0.f};
                    if (isctx) { if (ip >= 0) hp[bj] = *(const PG8_LAS f32x4*)(hs + (bj * 3 + ip) * 32 + 8 * fq + 4 * n); if (in >= 0) hn[bj] = *(const PG8_LAS f32x4*)(hs + (bj * 3 + in) * 32 + 8 * fq + 4 * n); } }
#pragma unroll
                for (int m = 0; m < 4; ++m) {
                    f32x4 o[2];
#pragma unroll
                    for (int bj = 0; bj < 2; ++bj) {
                        const f32x4 cur = acc[ai][bj][m][n];
                        const f32x4 offp = (fr == 15 && m > 0) ? acc[ai][bj][m > 0 ? m - 1 : 0][n] : cur;
                        const f32x4 offn = (fr == 0 && m < 3) ? acc[ai][bj][m < 3 ? m + 1 : 3][n] : cur;
                        f32x4 pv, nv;
#pragma unroll
                        for (int e = 0; e < 4; ++e) { pv[e] = __shfl(offp[e], lprev, 64); nv[e] = __shfl(offn[e], lnext, 64); }
                        if (m == 0) pv = fr == 0 ? hp[bj] : pv;
                        if (m == 3) nv = fr == 15 ? hn[bj] : nv;
                        o[bj] = bb[bj] + w0[bj] * pv + w1[bj] * cur + w2[bj] * nv;
                    }
                    float a0 = o[0][0], a1 = o[0][1], a2 = o[0][2], a3 = o[0][3];
                    u32x2 w; w.x = cvt_pk_bf16(a0 * sigm(a0) * o[1][0], a1 * sigm(a1) * o[1][1]); w.y = cvt_pk_bf16(a2 * sigm(a2) * o[1][2], a3 * sigm(a3) * o[1][3]);
                    *(u32x2*)(ACT + (size_t)(row0 + ai * HALF + m * 16) * DFF_ + ocol + 4 * n) = w;
                }
            }
        }
    }
};

template <class Epi, class Sched, bool ALIGN_EPI = false, bool SP2 = false>
__device__ __forceinline__ void gemm_phase(PG8_LAS unsigned char* lds, const Gemm g, const Sched& S, const Epi& E) {
    const int tid = threadIdx.x, wid = __builtin_amdgcn_readfirstlane(tid >> 6), lane = tid & 63, wr = wid >> 2, wc = wid & 3, fr = lane & 15, fq = lane >> 4;
    const int K = g.K, nt = K / BK;
    unsigned voffA[2], voffB[2];
#pragma unroll
    for (int i = 0; i < 2; ++i) { int R, C; stage_rc(tid * 16 + i * 8192, R, C); const int Rb = Epi::PERM ? ((R & ~31) + perm32(R & 31)) : R;
        voffA[i] = (unsigned)(R * K + C) * 2u; voffB[i] = (unsigned)(Rb * K + C) * 2u; }
    const size_t kstep = (size_t)(BK * 2);
    const size_t hstep = (size_t)HALF * K * 2;
    const size_t tstep = 2 * hstep;
    const unsigned ldsw = (unsigned)wid * 1024u;
    const int aoff = lds_byte(wr * 64 + fr, fq * 8), boff = lds_byte(wc * 32 + fr, fq * 8);
#define PG8_SA(b, h) (((b) * 2 + (h)) * HTB)
#define PG8_SB(b, h) ((4 + (b) * 2 + (h)) * HTB)
#define PG8_STAGE(bufoff, gbase, voff) do { _Pragma("unroll") for (int _i = 0; _i < 2; ++_i) \
        __builtin_amdgcn_global_load_lds((const unsigned*)((const char*)(gbase) + (voff)[_i]), (PG8_LAS unsigned*)(lds + (bufoff) + ldsw + _i * 8192), 16, 0, 0); } while (0)
#define PG8_LDA(dst, b, h) do { _Pragma("unroll") for (int m = 0; m < 4; ++m) _Pragma("unroll") for (int k = 0; k < 2; ++k) dst[m][k] = *(const PG8_LAS bf16x8*)(lds + PG8_SA(b, h) + aoff + m * 2048 + k * 1024); } while (0)
#define PG8_LDB(dst, b, h) do { _Pragma("unroll") for (int n = 0; n < 2; ++n) _Pragma("unroll") for (int k = 0; k < 2; ++k) dst[n][k] = *(const PG8_LAS bf16x8*)(lds + PG8_SB(b, h) + boff + n * 2048 + k * 1024); } while (0)
#define PG8_MMA(ai, bj, At, Bt) do { __builtin_amdgcn_s_setprio(1); _Pragma("unroll") for (int m = 0; m < 4; ++m) _Pragma("unroll") for (int n = 0; n < 2; ++n) _Pragma("unroll") for (int k = 0; k < 2; ++k) \
        acc[ai][bj][m][n] = __builtin_amdgcn_mfma_f32_16x16x32_bf16(Bt[n][k], At[m][k], acc[ai][bj][m][n], 0, 0, 0); __builtin_amdgcn_s_setprio(0); } while (0)
#define PG8_WAIT_V(n) asm volatile("s_waitcnt vmcnt(" #n ")" ::: "memory")
#define PG8_WAIT_L(n) asm volatile("s_waitcnt lgkmcnt(" #n ")" ::: "memory")
#define PG8_BAR __builtin_amdgcn_s_barrier()
#define PG8_SCHED __builtin_amdgcn_sched_barrier(0)
    Unit cur, nxt; int ui = 0;
    if (!S.next(0, cur)) return;
    f32x4 acc[2][2][4][2];
#pragma unroll
    for (int a = 0; a < 2; ++a)
#pragma unroll
        for (int b = 0; b < 2; ++b)
#pragma unroll
            for (int m = 0; m < 4; ++m)
#pragma unroll
                for (int n = 0; n < 2; ++n) acc[a][b][m][n] = (f32x4){0.f, 0.f, 0.f, 0.f};
    bf16x8 At[4][2], B0[2][2], B1[2][2];
    const char* cA = (const char*)g.A + (size_t)cur.pm * tstep; const char* cB = (const char*)g.Bt + (size_t)cur.pn * tstep;
    S.a_ready(cur);
    if constexpr (SP2) {
        PG8_STAGE(PG8_SB(0, 0), cB, voffB); PG8_STAGE(PG8_SB(0, 1), cB + hstep, voffB); PG8_STAGE(PG8_SA(0, 0), cA, voffA); PG8_STAGE(PG8_SA(0, 1), cA + hstep, voffA);
        if (wr == 1) PG8_BAR;
        PG8_WAIT_V(2); PG8_BAR;
        PG8_STAGE(PG8_SB(1, 0), cB + kstep, voffB); PG8_STAGE(PG8_SA(1, 0), cA + kstep, voffA); PG8_STAGE(PG8_SB(1, 1), cB + hstep + kstep, voffB);
        PG8_WAIT_V(6); PG8_BAR;
    } else {
        PG8_STAGE(PG8_SB(0, 0), cB, voffB); PG8_STAGE(PG8_SA(0, 0), cA, voffA); PG8_STAGE(PG8_SB(0, 1), cB + hstep, voffB); PG8_STAGE(PG8_SA(0, 1), cA + hstep, voffA);
        if (wr == 1) PG8_BAR;
        PG8_WAIT_V(4); PG8_BAR;
        PG8_STAGE(PG8_SB(1, 0), cB + kstep, voffB); PG8_STAGE(PG8_SA(1, 0), cA + kstep, voffA); PG8_STAGE(PG8_SB(1, 1), cB + hstep + kstep, voffB);
        PG8_WAIT_V(6); PG8_BAR;
    }
    for (;;) {
        const bool has_next = S.next(ui + 1, nxt);
        const char* nA = has_next ? (const char*)g.A + (size_t)nxt.pm * tstep : cA; const char* nB = has_next ? (const char*)g.Bt + (size_t)nxt.pn * tstep : cB;
        for (int t = 0; t < nt; t += 2) {
            const bool last = (t == nt - 2);
            const char* a1 = cA + (size_t)(t + 1) * kstep;
            const char* a2 = last ? nA : cA + (size_t)(t + 2) * kstep; const char* b2 = last ? nB : cB + (size_t)(t + 2) * kstep;
            const char* a3 = a2 + kstep; const char* b3 = b2 + kstep;
            if (last && has_next) S.a_ready(nxt);
            if constexpr (SP2) {
            PG8_LDB(B0, 0, 0); PG8_LDB(B1, 0, 1); PG8_SCHED; PG8_LDA(At, 0, 0); PG8_STAGE(PG8_SA(1, 1), a1 + hstep, voffA);
            PG8_WAIT_V(8); PG8_WAIT_L(0); PG8_BAR; PG8_MMA(0, 0, At, B0); PG8_MMA(0, 1, At, B1); PG8_BAR; PG8_SCHED;
            PG8_LDA(At, 0, 1); PG8_STAGE(PG8_SB(0, 0), b2, voffB); PG8_STAGE(PG8_SB(0, 1), b2 + hstep, voffB); PG8_STAGE(PG8_SA(0, 0), a2, voffA);
            PG8_WAIT_V(8); PG8_WAIT_L(0); PG8_BAR; PG8_MMA(1, 0, At, B0); PG8_MMA(1, 1, At, B1); PG8_BAR; PG8_SCHED;
            PG8_LDB(B0, 1, 0); PG8_LDB(B1, 1, 1); PG8_SCHED; PG8_LDA(At, 1, 0); PG8_STAGE(PG8_SA(0, 1), a2 + hstep, voffA);
            PG8_WAIT_V(8); PG8_WAIT_L(0); PG8_BAR; PG8_MMA(0, 0, At, B0); PG8_MMA(0, 1, At, B1); PG8_BAR; PG8_SCHED;
            PG8_LDA(At, 1, 1); PG8_STAGE(PG8_SB(1, 0), b3, voffB); PG8_STAGE(PG8_SB(1, 1), b3 + hstep, voffB); PG8_STAGE(PG8_SA(1, 0), a3, voffA);
            PG8_WAIT_V(8); PG8_WAIT_L(0); PG8_BAR; PG8_MMA(1, 0, At, B0); PG8_MMA(1, 1, At, B1); PG8_BAR; PG8_SCHED;
            } else {
            PG8_LDB(B0, 0, 0); PG8_SCHED; PG8_LDA(At, 0, 0); PG8_STAGE(PG8_SA(1, 1), a1 + hstep, voffA);
            PG8_WAIT_L(8); PG8_BAR; PG8_WAIT_L(0); PG8_MMA(0, 0, At, B0); PG8_BAR; PG8_SCHED;
            PG8_LDB(B1, 0, 1); PG8_STAGE(PG8_SB(0, 0), b2, voffB);
            PG8_BAR; PG8_WAIT_L(0); PG8_MMA(0, 1, At, B1); PG8_BAR;
            PG8_LDA(At, 0, 1); PG8_STAGE(PG8_SA(0, 0), a2, voffA);
            PG8_BAR; PG8_WAIT_L(0); PG8_MMA(1, 0, At, B0); PG8_BAR; PG8_SCHED;
            PG8_STAGE(PG8_SB(0, 1), b2 + hstep, voffB);
            PG8_WAIT_V(6); PG8_BAR; PG8_MMA(1, 1, At, B1); PG8_BAR;
            PG8_LDB(B0, 1, 0); PG8_SCHED; PG8_LDA(At, 1, 0); PG8_STAGE(PG8_SA(0, 1), a2 + hstep, voffA);
            PG8_WAIT_L(8); PG8_BAR; PG8_WAIT_L(0); PG8_MMA(0, 0, At, B0); PG8_BAR; PG8_SCHED;
            PG8_LDB(B1, 1, 1); PG8_STAGE(PG8_SB(1, 0), b3, voffB);
            PG8_BAR; PG8_WAIT_L(0); PG8_MMA(0, 1, At, B1); PG8_BAR;
            PG8_LDA(At, 1, 1); PG8_STAGE(PG8_SA(1, 0), a3, voffA);
            PG8_BAR; PG8_WAIT_L(0); PG8_MMA(1, 0, At, B0); PG8_BAR; PG8_SCHED;
            PG8_STAGE(PG8_SB(1, 1), b3 + hstep, voffB);
            PG8_WAIT_V(6); PG8_BAR; PG8_MMA(1, 1, At, B1); PG8_BAR;
            }
        }
        if constexpr (ALIGN_EPI) { if (wr == 0) PG8_BAR; }
        if constexpr (!Epi::AFTER_DRAIN) { E(acc, cur, wr, wc, fr, fq); S.done(cur); }
        if (!has_next) break;
#pragma unroll
        for (int a = 0; a < 2; ++a)
#pragma unroll
            for (int b = 0; b < 2; ++b)
#pragma unroll
                for (int m = 0; m < 4; ++m)
#pragma unroll
                    for (int n = 0; n < 2; ++n) acc[a][b][m][n] = (f32x4){0.f, 0.f, 0.f, 0.f};
        cur = nxt; cA = nA; cB = nB; ++ui;
        if constexpr (ALIGN_EPI) { if (wr == 1) PG8_BAR; }
    }
    PG8_WAIT_V(0);
    if constexpr (!ALIGN_EPI) { if (wr == 0) PG8_BAR; }
    PG8_BAR;
    if constexpr (Epi::AFTER_DRAIN) { E.fused(acc, cur, wr, wc, fr, fq, lds, wid, lane); S.done(cur); }
#undef PG8_SA
#undef PG8_SB
#undef PG8_STAGE
#undef PG8_LDA
#undef PG8_LDB
#undef PG8_MMA
#undef PG8_WAIT_V
#undef PG8_WAIT_L
#undef PG8_BAR
#undef PG8_SCHED
}
}

#define LAS __attribute__((address_space(3)))
constexpr int LDS_BYTES = 147456;
constexpr int HALO_OFF = 132096;
template <class Epi> __device__ __forceinline__ void epi_set_lds(Epi&, LAS unsigned char*) {}
template <> __device__ __forceinline__ void epi_set_lds<pg8::EpiUpConv>(pg8::EpiUpConv& E, LAS unsigned char* lds) { E.halo = (LAS float*)(lds + HALO_OFF); }
template <class Epi, bool ALIGN> __global__ __launch_bounds__(512, 2) void k_gemm_phase(pg8::Gemm g, Epi E) {
    extern __shared__ __attribute__((aligned(16))) unsigned char lds[];
    pg8::StaticOrder S; S.init(g.M, g.N, (int)gridDim.x, (int)blockIdx.x);
    epi_set_lds(E, (LAS unsigned char*)lds);
    pg8::gemm_phase<Epi, pg8::StaticOrder, ALIGN, true>((LAS unsigned char*)lds, g, S, E);
}

__global__ void k_mod(const float* c, const float* cctx, const float* wmod, const float* bmod, float* mod) {
    const int idx = blockIdx.x * blockDim.x + threadIdx.x;
    if (idx >= DEPTH * 5 * 6 * D) return;
    const int j = idx % (6 * D), r = (idx / (6 * D)) % 5, l = idx / (6 * D * 5);
    const float* cv = r < 4 ? c + r * D : cctx;
    const float* w = wmod + (size_t)l * D * 6 * D + j;
    float acc = bmod[l * 6 * D + j];
    for (int k = 0; k < D; ++k) acc += siluf_(cv[k]) * w[(size_t)k * 6 * D];
    mod[idx] = acc;
}
__global__ void k_lb(const float* hglb, float* lb) {
    const int idx = blockIdx.x * blockDim.x + threadIdx.x;
    if (idx >= 2 * HGW) return;
    float v[DEPTH], mx = -1e30f;
#pragma unroll
    for (int l = 0; l < DEPTH; ++l) { v[l] = hglb[l * 2 * HGW + idx]; mx = fmaxf(mx, v[l]); }
    float s = 0.f;
#pragma unroll
    for (int l = 0; l < DEPTH; ++l) { v[l] = __expf(v[l] - mx); s += v[l]; }
    float cum = 0.f, first = 0.f;
#pragma unroll
    for (int l = 0; l < DEPTH; ++l) { cum += v[l] / s; if (l == 0) first = cum; lb[l * 2 * HGW + idx] = cum - first; }
}
__global__ void k_s5disc(const float* lre, const float* lim, const float* ldt, const float* bre, const float* bim, float* ab, float* bb) {
    const int idx = blockIdx.x * blockDim.x + threadIdx.x;
    if (idx >= DEPTH * 2 * S5G * S5P) return;
    const int ldg = idx / S5P;
    const float lr = lre[idx], li = lim[idx], dt = expf(ldt[ldg]);
    const float mag = expf(lr * dt), ang = li * dt;
    const float ar = mag * cosf(ang), ai = mag * sinf(ang);
    ab[idx * 2] = ar; ab[idx * 2 + 1] = ai;
    const float den = lr * lr + li * li, nr = ar - 1.f, ni = ai;
    const float cr = (nr * lr + ni * li) / den, ci = (ni * lr - nr * li) / den;
    for (int h = 0; h < S5H; ++h) {
        const float br = bre[(size_t)idx * S5H + h], bi = bim[(size_t)idx * S5H + h];
        bb[((size_t)idx * S5H + h) * 2] = cr * br - ci * bi; bb[((size_t)idx * S5H + h) * 2 + 1] = cr * bi + ci * br;
    }
}
__global__ void k_copy(const float* a, float* b, size_t n) { for (size_t i = (size_t)blockIdx.x * blockDim.x + threadIdx.x; i < n; i += (size_t)gridDim.x * blockDim.x) b[i] = a[i]; }
__global__ void __launch_bounds__(256) k_wprep(const float* W, bf16* Wt, int K, int N, int mode) {
    __shared__ float tile[64][65];
    const int n0 = blockIdx.x * 64, k0 = blockIdx.y * 64, tx = threadIdx.x & 63, ty = threadIdx.x >> 6;
    const int np = n0 + tx; const int nsrc = mode == 1 ? (((np & 255) < 128 ? 0 : DFF) + 128 * (np >> 8) + (np & 127)) : np;
    for (int i = ty; i < 64; i += 4) tile[i][tx] = W[(size_t)(k0 + i) * N + nsrc];
    __syncthreads();
    for (int i = ty; i < 64; i += 4) Wt[(size_t)(n0 + i) * K + k0 + tx] = f2bf(tile[tx][i]);
}

__device__ __forceinline__ float* xrow_ptr(float* xc, float* xo, int r) { return r < MC ? xc + (size_t)r * D : xo + (size_t)(r - MC) * D; }
__global__ void k_modulate(float* xc, float* xo, const float* modl, int off_sh, int off_sc, bf16* H) {
    const int r = blockIdx.x; const float* x = xrow_ptr(xc, xo, r); const float* mr = modl + (size_t)row_modidx(r) * 6 * D;
    for (int k = threadIdx.x; k < D; k += blockDim.x) H[(size_t)r * D + k] = f2bf(x[k] * (1.f + mr[off_sc + k]) + mr[off_sh + k]);
}
__global__ void __launch_bounds__(256) k_ln(float* xc, float* xo, const float* lg, const float* lbv, const float* modn, int off_sh, int off_sc, bf16* H) {
    const int r = blockIdx.x; float* x = xrow_ptr(xc, xo, r);
    __shared__ float red[4];
    float z[4]; float s = 0.f;
#pragma unroll
    for (int j = 0; j < 4; ++j) { const int k = threadIdx.x + 256 * j; z[j] = x[k]; s += z[j]; }
    for (int off = 32; off >= 1; off >>= 1) s += __shfl_xor(s, off);
    if ((threadIdx.x & 63) == 0) red[threadIdx.x >> 6] = s;
    __syncthreads();
    const float mean = (red[0] + red[1] + red[2] + red[3]) * (1.f / D);
    __syncthreads();
    float q = 0.f;
#pragma unroll
    for (int j = 0; j < 4; ++j) { z[j] -= mean; q += z[j] * z[j]; }
    for (int off = 32; off >= 1; off >>= 1) q += __shfl_xor(q, off);
    if ((threadIdx.x & 63) == 0) red[threadIdx.x >> 6] = q;
    __syncthreads();
    const float rstd = rsqrtf((red[0] + red[1] + red[2] + red[3]) * (1.f / D) + LN_EPS);
    const float* mr = modn ? modn + (size_t)row_modidx(r) * 6 * D : nullptr;
#pragma unroll
    for (int j = 0; j < 4; ++j) { const int k = threadIdx.x + 256 * j; const float v = z[j] * rstd * lg[k] + lbv[k]; x[k] = v;
        if (mr) H[(size_t)r * D + k] = f2bf(v * (1.f + mr[off_sc + k]) + mr[off_sh + k]); }
}

__device__ __forceinline__ int s5_row(int b, int d, int s) {
    if (s < CTX) { const int t = d ? CTX - 1 - s : s; return b * CTX + t; }
    const int t = d ? SEQ - 1 - (s - CTX) : (s - CTX); return MC + b * SEQ + t;
}
__global__ void __launch_bounds__(64) k_s5(const bf16* P, const float* abl, const float* bbl, const float* crel, const float* ciml, bf16* YF, bf16* YB) {
    const int b = blockIdx.x / (S5G * 2), g = (blockIdx.x / 2) % S5G, d = blockIdx.x & 1, p = threadIdx.x;
    __shared__ float xs[16][128];
    __shared__ float cs[16][128];
    const int dgp = (d * S5G + g) * S5P + p;
    const float ar = abl[dgp * 2], ai = abl[dgp * 2 + 1];
    float br[16], bi[16];
#pragma unroll
    for (int h = 0; h < 16; ++h) { br[h] = bbl[((size_t)dgp * 16 + h) * 2]; bi[h] = bbl[((size_t)dgp * 16 + h) * 2 + 1]; }
    for (int h = 0; h < 16; ++h) { cs[h][p] = crel[((size_t)(d * S5G + g) * S5H + h) * S5P + p]; cs[h][64 + p] = ciml[((size_t)(d * S5G + g) * S5H + h) * S5P + p]; }
    bf16* Y = d ? YB : YF;
    float xr = 0.f, xi = 0.f;
    const int NT = CTX + SEQ;
    for (int s0 = 0; s0 < NT; s0 += 16) {
#pragma unroll 4
        for (int i = 0; i < 16; ++i) {
            const int row = s5_row(b, d, s0 + i);
            const bf16* u = P + (size_t)row * INC + g * 16;
            float sr = 0.f, si = 0.f;
#pragma unroll
            for (int h = 0; h < 16; ++h) { const float uv = bf2f(u[h]); sr += br[h] * uv; si += bi[h] * uv; }
            const float nr = ar * xr - ai * xi + sr, ni = ar * xi + ai * xr + si;
            xr = nr; xi = ni;
            xs[i][p] = xr; xs[i][64 + p] = xi;
        }
        __syncthreads();
        { const int t = p >> 2, h0 = (p & 3) * 4; const int row = s5_row(b, d, s0 + t);
#pragma unroll
          for (int hh = 0; hh < 4; ++hh) { const int h = h0 + hh; float acc = 0.f;
              for (int q = 0; q < 64; ++q) acc += xs[t][q] * cs[h][q] - xs[t][64 + q] * cs[h][64 + q];
              Y[(size_t)row * S5W + g * 16 + h] = f2bf(acc); } }
        __syncthreads();
    }
}
__global__ void __launch_bounds__(128) k_gla(const bf16* P, const float* lbl, bf16* OF, bf16* OB) {
    const int b = blockIdx.x / (NH * 2), hd = (blockIdx.x / 2) % NH, d = blockIdx.x & 1, v = threadIdx.x;
    __shared__ float fs[128], ks[128], qs[128];
    float S[128];
#pragma unroll
    for (int k = 0; k < 128; ++k) S[k] = 0.f;
    const float lbv = lbl[d * HGW + hd * HD + v];
    bf16* O = d ? OB : OF;
    const int NT = CTX + SEQ;
    for (int s = 0; s < NT; ++s) {
        const int row = s5_row(b, d, s);
        const bf16* pr = P + (size_t)row * INC;
        const float fr = bf2f(pr[512 + d * 512 + hd * HD + v]);
        const float f = lbv + (1.f - lbv) * sigmoidf_(fr);
        fs[v] = f; ks[v] = 1.f - f; qs[v] = siluf_(bf2f(pr[2048 + hd * HD + v]));
        const float vv = bf2f(pr[1536 + hd * HD + v]);
        __syncthreads();
        float o = 0.f;
#pragma unroll
        for (int k = 0; k < 128; ++k) { S[k] = fs[k] * S[k] + ks[k] * vv; o += S[k] * qs[k]; }
        O[(size_t)row * HGW + hd * HD + v] = f2bf(o);
        __syncthreads();
    }
}
__global__ void __launch_bounds__(512) k_mixout(const bf16* P, const bf16* YF, const bf16* YB, const bf16* OF, const bf16* OB, const float* sd, const float* nw, bf16* S5Y, bf16* Y) {
    const int r = blockIdx.x, c = threadIdx.x;
    __shared__ float red[8];
    const bf16* pr = P + (size_t)r * INC;
    const float y = bf2f(YF[(size_t)r * S5W + c]) + bf2f(YB[(size_t)r * S5W + c]) + bf2f(pr[c]) * sd[c];
    S5Y[(size_t)r * S5W + c] = f2bf(gelu_tanh(y));
    const float o = bf2f(OF[(size_t)r * HGW + c]) + bf2f(OB[(size_t)r * HGW + c]);
    float s = o * o;
    for (int off = 32; off >= 1; off >>= 1) s += __shfl_xor(s, off);
    if ((c & 63) == 0) red[c >> 6] = s;
    __syncthreads();
    const float ms = (red[(c >> 7) * 2] + red[(c >> 7) * 2 + 1]) * (1.f / 128.f);
    const float g = bf2f(pr[2560 + c]);
    Y[(size_t)r * D + 512 + c] = f2bf(o * rsqrtf(ms + RMS_EPS) * nw[c & 127] * siluf_(g));
}

constexpr size_t MiB = 1u << 20;
constexpr size_t WS_CTL = 0, WS_MISC = 1 * MiB, WS_XC = 5 * MiB, WS_WIN = 9 * MiB, WS_WGLU = 33 * MiB, WS_WOUT = 35 * MiB, WS_WUP = 43 * MiB, WS_WDN = 87 * MiB,
                 WS_H = 109 * MiB, WS_P = 143 * MiB, WS_YFB = 245 * MiB, WS_OFB = 279 * MiB, WS_S5Y = 313 * MiB, WS_Y = 330 * MiB, WS_END = 364 * MiB;
constexpr size_t WS_ACT = WS_P;
static_assert((size_t)M * INC * 2 <= 102 * MiB && (size_t)M * D * 2 <= 34 * MiB && (size_t)M * DFF * 2 <= 102 * MiB, "ws map");

template <class Epi, bool ALIGN> static void launch_gemm(const pg8::Gemm& g, const Epi& E, hipStream_t st) {
    static bool attr = false; if (!attr) { (void)hipFuncSetAttribute((const void*)k_gemm_phase<Epi, ALIGN>, hipFuncAttributeMaxDynamicSharedMemorySize, LDS_BYTES); attr = true; }
    hipLaunchKernelGGL((k_gemm_phase<Epi, ALIGN>), dim3(256), dim3(512), LDS_BYTES, st, g, E);
}

extern "C" void kernel_launch(void* const* d_in, const int* in_sizes, int n_in, void* d_out, int out_size, void* d_ws, size_t ws_size, hipStream_t stream) {
    const float* in[N_IN]; for (int i = 0; i < N_IN; ++i) in[i] = (const float*)d_in[i];
    if (ws_size < WS_END) { fprintf(stderr, "ws too small: need %zu have %zu\n", (size_t)WS_END, ws_size); return; }
    float* out = (float*)d_out; char* ws = (char*)d_ws;
    float* MOD = (float*)(ws + WS_MISC); float* LB = MOD + DEPTH * 5 * 6 * D; float* AB = LB + DEPTH * 2 * HGW; float* BB = AB + DEPTH * 2 * S5G * S5P * 2;
    float* XC = (float*)(ws + WS_XC);
    bf16* WIN = (bf16*)(ws + WS_WIN); bf16* WGLU = (bf16*)(ws + WS_WGLU); bf16* WOUT = (bf16*)(ws + WS_WOUT); bf16* WUP = (bf16*)(ws + WS_WUP); bf16* WDN = (bf16*)(ws + WS_WDN);
    bf16* H = (bf16*)(ws + WS_H); bf16* P = (bf16*)(ws + WS_P); bf16* ACT = (bf16*)(ws + WS_ACT);
    bf16* YF = (bf16*)(ws + WS_YFB); bf16* YB = YF + (size_t)M * S5W; bf16* OF = (bf16*)(ws + WS_OFB); bf16* OB = OF + (size_t)M * HGW;
    bf16* S5Y = (bf16*)(ws + WS_S5Y); bf16* Y = (bf16*)(ws + WS_Y);

    k_mod<<<(DEPTH * 5 * 6 * D + 255) / 256, 256, 0, stream>>>(in[I_C], in[I_CCTX], in[I_WMOD], in[I_BMOD], MOD);
    k_lb<<<(2 * HGW + 255) / 256, 256, 0, stream>>>(in[I_HGLB], LB);
    k_s5disc<<<(DEPTH * 2 * S5G * S5P + 255) / 256, 256, 0, stream>>>(in[I_LRE], in[I_LIM], in[I_LDT], in[I_BRE], in[I_BIM], AB, BB);
    k_copy<<<2048, 256, 0, stream>>>(in[I_X], out, (size_t)MX * D);
    k_copy<<<512, 256, 0, stream>>>(in[I_CTX], XC, (size_t)MC * D);
    for (int l = 0; l < DEPTH; ++l) {
        k_wprep<<<dim3(INC / 64, D / 64), 256, 0, stream>>>(in[I_WIN] + (size_t)l * D * INC, WIN + (size_t)l * INC * D, D, INC, 0);
        k_wprep<<<dim3(S5W / 64, S5W / 64), 256, 0, stream>>>(in[I_WGLU] + (size_t)l * S5W * S5W, WGLU + (size_t)l * S5W * S5W, S5W, S5W, 0);
        k_wprep<<<dim3(D / 64, D / 64), 256, 0, stream>>>(in[I_WOUT] + (size_t)l * D * D, WOUT + (size_t)l * D * D, D, D, 0);
        k_wprep<<<dim3(2 * DFF / 64, D / 64), 256, 0, stream>>>(in[I_WUP] + (size_t)l * D * 2 * DFF, WUP + (size_t)l * 2 * DFF * D, D, 2 * DFF, 1);
        k_wprep<<<dim3(D / 64, DFF / 64), 256, 0, stream>>>(in[I_WDOWN] + (size_t)l * DFF * D, WDN + (size_t)l * D * DFF, DFF, D, 0);
    }
    k_modulate<<<M, 256, 0, stream>>>(XC, out, MOD, 0, D, H);
    for (int l = 0; l < DEPTH; ++l) {
        const float* modl = MOD + (size_t)l * 5 * 6 * D;
        { pg8::Gemm g{H, WIN + (size_t)l * INC * D, M, INC, D}; pg8::EpiBf16Plain E{P, INC}; launch_gemm<pg8::EpiBf16Plain, true>(g, E, stream); }
        k_s5<<<BATCH * S5G * 2, 64, 0, stream>>>(P, AB + (size_t)l * 2 * S5G * S5P * 2, BB + (size_t)l * 2 * S5G * S5P * S5H * 2,
                                                   in[I_CRE] + (size_t)l * 2 * S5G * S5H * S5P, in[I_CIM] + (size_t)l * 2 * S5G * S5H * S5P, YF, YB);
        k_gla<<<BATCH * NH * 2, 128, 0, stream>>>(P, LB + (size_t)l * 2 * HGW, OF, OB);
        k_mixout<<<M, 512, 0, stream>>>(P, YF, YB, OF, OB, in[I_SD] + (size_t)l * S5W, in[I_HGNW] + (size_t)l * HD, S5Y, Y);
        { pg8::Gemm g{S5Y, WGLU + (size_t)l * S5W * S5W, M, S5W, S5W}; pg8::EpiGlu E{Y, S5Y, in[I_BGLU] + (size_t)l * S5W}; launch_gemm<pg8::EpiGlu, true>(g, E, stream); }
        { pg8::Gemm g{Y, WOUT + (size_t)l * D * D, M, D, D}; pg8::EpiResid E{XC, out, modl, 2 * D}; launch_gemm<pg8::EpiResid, true>(g, E, stream); }
        k_ln<<<M, 256, 0, stream>>>(XC, out, in[I_LN1G] + (size_t)l * D, in[I_LN1B] + (size_t)l * D, modl, 3 * D, 4 * D, H);
        { pg8::Gemm g{H, WUP + (size_t)l * 2 * DFF * D, M, 2 * DFF, D};
          pg8::EpiUpConv E{ACT, in[I_CONVW] + (size_t)l * 3 * 2 * DFF, in[I_CONVB] + (size_t)l * 2 * DFF, H, WUP + (size_t)l * 2 * DFF * D, nullptr}; launch_gemm<pg8::EpiUpConv, true>(g, E, stream); }
        { pg8::Gemm g{ACT, WDN + (size_t)l * D * DFF, M, D, DFF}; pg8::EpiResid E{XC, out, modl, 5 * D}; launch_gemm<pg8::EpiResid, true>(g, E, stream); }
        k_ln<<<M, 256, 0, stream>>>(XC, out, in[I_LN2G] + (size_t)l * D, in[I_LN2B] + (size_t)l * D, l + 1 < DEPTH ? modl + 5 * 6 * D : nullptr, 0, D, H);
    }
}
```

```cpp
#include <hip/hip_runtime.h>
#include <cstdio>
#include <cstdint>

constexpr int D = 1024, BATCH = 4, SEQ = 4096, DEPTH = 4, CTX = 256;
constexpr int S5W = 512, S5G = 32, S5H = 16, S5P = 64, HGW = 512, HD = 128, NH = 4;
constexpr int DFF = 2816, INC = 3072;
constexpr int MC = BATCH * CTX;
constexpr int MX = BATCH * SEQ;
constexpr int M = MC + MX;
constexpr float ALPHA = 1.681792830507429f;
constexpr float LN_EPS = 1e-5f, RMS_EPS = 1e-6f;

enum { I_X = 0, I_C, I_CTX, I_CCTX, I_WMOD, I_BMOD, I_WIN, I_LRE, I_LIM, I_LDT, I_BRE, I_BIM, I_CRE, I_CIM, I_SD, I_WGLU, I_BGLU,
       I_HGLB, I_HGNW, I_WOUT, I_LN1G, I_LN1B, I_WUP, I_CONVW, I_CONVB, I_WDOWN, I_LN2G, I_LN2B, N_IN };

typedef unsigned short bf16;
__device__ __forceinline__ float sigmoidf_(float x) { return 1.f / (1.f + __expf(-x)); }
__device__ __forceinline__ float siluf_(float x) { return x / (1.f + __expf(-x)); }
__device__ __forceinline__ float gelu_tanh(float x) { const float u = 0.7978845608028654f * (x + 0.044715f * x * x * x); return 0.5f * x * (1.f + tanhf(u)); }
__device__ __forceinline__ float bf2f(bf16 b) { return __uint_as_float(((unsigned)b) << 16); }
__device__ __forceinline__ bf16 f2bf(float f) { unsigned u = __float_as_uint(f); return (bf16)((u + 0x7fffu + ((u >> 16) & 1u)) >> 16); }
__host__ __device__ __forceinline__ int row_modidx(int r) { return r < MC ? 4 : (r - MC) / SEQ; }

namespace pg8 {
#define PG8_LAS __attribute__((address_space(3)))
typedef unsigned short bf16_t;
typedef short bf16x8 __attribute__((ext_vector_type(8)));
typedef float f32x4 __attribute__((ext_vector_type(4)));
typedef unsigned u32x4 __attribute__((ext_vector_type(4)));
constexpr int BM = 256, BK = 64, HALF = 128, HTB = HALF * BK * 2  , STAGE_BYTES = 8 * HTB, NXCD = 8, WGM = 8;

__host__ __device__ __forceinline__ int lds_byte(int r, int c) { const int st = (r >> 4) * 2 + (c >> 5), rr = r & 15, cc = c & 31, ob = rr * 64 + cc * 2; return st * 1024 + (ob ^ (((ob >> 9) & 1) << 5)); }
__host__ __device__ __forceinline__ void stage_rc(int b, int& R, int& C) { const int st = b / 1024, sb = b % 1024, swz = sb ^ (((sb >> 9) & 1) << 5); R = (st >> 1) * 16 + swz / 64; C = (st & 1) * 32 + (swz % 64) / 2; }
__host__ __device__ __forceinline__ int perm32(int rho) { const int n = rho >> 4, i = rho & 15; return 8 * (i >> 2) + 4 * n + (i & 3); }

struct Unit { int pm, pn; };
struct Gemm { const bf16_t* A; const bf16_t* Bt; int M, N, K, pad; };

struct StaticOrder {
    int nM, nN, nwg, G, c;
    __host__ __device__ void init(int M, int N, int G_, int c_) { nM = M / BM; nN = N / BM; nwg = nM * nN; G = G_; c = c_; }
    __host__ __device__ bool next(int i, Unit& u) const {
        const long L = (long)i * G + c; if (L >= nwg) return false;
        int wgid = (int)L; { const int q = nwg / NXCD, r = nwg % NXCD, xcd = wgid % NXCD, off = wgid / NXCD; wgid = (xcd < r ? xcd * (q + 1) : r * (q + 1) + (xcd - r) * q) + off; }
        const int nig = WGM * nN, gid = wgid / nig, fm = gid * WGM, gsz = (nM - fm) < WGM ? (nM - fm) : WGM;
        u.pm = fm + ((wgid % nig) % gsz); u.pn = (wgid % nig) / gsz; return true;
    }
    __device__ __forceinline__ void a_ready(const Unit&) const {}
    __device__ __forceinline__ void done(const Unit&) const {}
};
constexpr int DFF_ = 2816;
__device__ __forceinline__ unsigned cvt_pk_bf16(float lo, float hi) { unsigned r; asm volatile("v_cvt_pk_bf16_f32 %0, %1, %2" : "=v"(r) : "v"(lo), "v"(hi)); return r; }
typedef unsigned u32x2 __attribute__((ext_vector_type(2)));
__device__ __forceinline__ float bflo(unsigned w) { return __uint_as_float(w << 16); }
__device__ __forceinline__ float bfhi(unsigned w) { return __uint_as_float(w & 0xffff0000u); }
__device__ __forceinline__ float sigm(float x) { return __builtin_amdgcn_rcpf(1.f + __expf(-x)); }

struct EpiBf16Plain {
    static constexpr bool PERM = true, AFTER_DRAIN = false;
    bf16_t* O; int ldc, pad;
    __device__ __forceinline__ void operator()(const f32x4 (&acc)[2][2][4][2], const Unit& u, int wr, int wc, int fr, int fq) const {
        const int row0 = u.pm * BM + wr * 64 + fr, col0 = u.pn * BM + wc * 32 + 8 * fq;
#pragma unroll
        for (int ai = 0; ai < 2; ++ai)
#pragma unroll
            for (int m = 0; m < 4; ++m) { bf16_t* rowp = O + (size_t)(row0 + ai * HALF + m * 16) * ldc + col0;
#pragma unroll
                for (int bj = 0; bj < 2; ++bj) { const f32x4 v0 = acc[ai][bj][m][0], v1 = acc[ai][bj][m][1];
                    u32x4 w; w.x = cvt_pk_bf16(v0[0], v0[1]); w.y = cvt_pk_bf16(v0[2], v0[3]); w.z = cvt_pk_bf16(v1[0], v1[1]); w.w = cvt_pk_bf16(v1[2], v1[3]);
                    *(u32x4*)(rowp + bj * HALF) = w; } }
    }
};
struct EpiGlu {
    static constexpr bool PERM = true, AFTER_DRAIN = false;
    bf16_t* Y; const bf16_t* S5Y; const float* bias;
    __device__ __forceinline__ void operator()(const f32x4 (&acc)[2][2][4][2], const Unit& u, int wr, int wc, int fr, int fq) const {
        const int row0 = u.pm * BM + wr * 64 + fr, col0 = u.pn * BM + wc * 32 + 8 * fq;
        f32x4 bv[2][2];
#pragma unroll
        for (int bj = 0; bj < 2; ++bj)
#pragma unroll
            for (int n = 0; n < 2; ++n) bv[bj][n] = *(const f32x4*)(bias + col0 + bj * HALF + 4 * n);
#pragma unroll
        for (int ai = 0; ai < 2; ++ai)
#pragma unroll
            for (int m = 0; m < 4; ++m) { const size_t row = (size_t)(row0 + ai * HALF + m * 16);
#pragma unroll
                for (int bj = 0; bj < 2; ++bj) { const f32x4 v0 = acc[ai][bj][m][0] + bv[bj][0], v1 = acc[ai][bj][m][1] + bv[bj][1];
                    const u32x4 s = *(const u32x4*)(S5Y + row * 512 + col0 + bj * HALF);
                    u32x4 w;
                    w.x = cvt_pk_bf16(bflo(s.x) * sigm(v0[0]), bfhi(s.x) * sigm(v0[1])); w.y = cvt_pk_bf16(bflo(s.y) * sigm(v0[2]), bfhi(s.y) * sigm(v0[3]));
                    w.z = cvt_pk_bf16(bflo(s.z) * sigm(v1[0]), bfhi(s.z) * sigm(v1[1])); w.w = cvt_pk_bf16(bflo(s.w) * sigm(v1[2]), bfhi(s.w) * sigm(v1[3]));
                    *(u32x4*)(Y + row * 1024 + col0 + bj * HALF) = w; } }
    }
};
struct EpiResid {
    static constexpr bool PERM = false, AFTER_DRAIN = false;
    float* XC; float* XO; const float* modl; int off_gate, pad;
    __device__ __forceinline__ void operator()(const f32x4 (&acc)[2][2][4][2], const Unit& u, int wr, int wc, int fr, int fq) const {
        float* xb = u.pm < 4 ? XC + (size_t)u.pm * BM * 1024 : XO + (size_t)(u.pm - 4) * BM * 1024;
        const float* gate = modl + (size_t)(u.pm < 4 ? 4 : (u.pm - 4) >> 4) * 6144 + off_gate;
        const int rl0 = wr * 64 + fr, col0 = u.pn * BM + wc * 32 + 4 * fq;
        f32x4 gv[2][2];
#pragma unroll
        for (int bj = 0; bj < 2; ++bj)
#pragma unroll
            for (int n = 0; n < 2; ++n) gv[bj][n] = *(const f32x4*)(gate + col0 + bj * HALF + n * 16);
#pragma unroll
        for (int ai = 0; ai < 2; ++ai)
#pragma unroll
            for (int m = 0; m < 4; ++m) { float* rowp = xb + (size_t)(rl0 + ai * HALF + m * 16) * 1024 + col0;
#pragma unroll
                for (int bj = 0; bj < 2; ++bj)
#pragma unroll
                    for (int n = 0; n < 2; ++n) { f32x4* p = (f32x4*)(rowp + bj * HALF + n * 16); const f32x4 x = *p; *p = x * 1.681792830507429f + gv[bj][n] * acc[ai][bj][m][n]; }
                asm volatile("" ::: "memory"); }
    }
};
struct EpiUpConv {
    static constexpr bool PERM = true, AFTER_DRAIN = false;
    bf16_t* ACT; const float* cw; const float* cb; const bf16_t* H; const bf16_t* Wt; PG8_LAS float* halo; int pad;
    __device__ __forceinline__ void operator()(const f32x4 (&acc)[2][2][4][2], const Unit& u, int wr, int wc, int fr, int fq) const {
        const int lane = fq * 16 + fr;
        const bool isctx = u.pm < 4;
        PG8_LAS float* hs = halo + (wr * 4 + wc) * 192;
        if (isctx) {
            const int r0 = wr == 0 ? 64 : 63, r1 = wr == 0 ? 127 : 128, r2 = wr == 0 ? 192 : 191;
            const int hi = lane & 15, hrow = hi == 1 ? r1 : (hi == 2 ? r2 : r0);
            const bf16_t* ap = H + (size_t)(u.pm * BM + hrow) * 1024 + 8 * (lane >> 4);
            const bf16_t* bp = Wt + (size_t)(u.pn * BM + wc * 32 + (lane & 15)) * 1024 + 8 * (lane >> 4);
            f32x4 h4[2][2];
#pragma unroll
            for (int bj = 0; bj < 2; ++bj)
#pragma unroll
                for (int nt = 0; nt < 2; ++nt) h4[bj][nt] = (f32x4){0.f, 0.f, 0.f, 0.f};
#pragma unroll 4
            for (int ks = 0; ks < 32; ++ks) {
                const bf16x8 a = *(const bf16x8*)(ap + 32 * ks);
#pragma unroll
                for (int bj = 0; bj < 2; ++bj)
#pragma unroll
                    for (int nt = 0; nt < 2; ++nt) { const bf16x8 b = *(const bf16x8*)(bp + (size_t)(bj * HALF + nt * 16) * 1024 + 32 * ks);
                        h4[bj][nt] = __builtin_amdgcn_mfma_f32_16x16x32_bf16(a, b, h4[bj][nt], 0, 0, 0); }
            }
            if (lane < 16) {
#pragma unroll
                for (int bj = 0; bj < 2; ++bj)
#pragma unroll
                    for (int nt = 0; nt < 2; ++nt) { hs[(bj * 3 + 0) * 32 + nt * 16 + lane] = h4[bj][nt][0]; hs[(bj * 3 + 1) * 32 + nt * 16 + lane] = h4[bj][nt][1]; hs[(bj * 3 + 2) * 32 + nt * 16 + lane] = h4[bj][nt][2]; }
            }
            asm volatile("s_waitcnt lgkmcnt(0)" ::: "memory");
        }
        const int lprev = (lane & 48) | ((lane - 1) & 15), lnext = (lane & 48) | ((lane + 1) & 15);
        const int row0 = u.pm * BM + wr * 64 + fr, ocol = u.pn * HALF + wc * 32 + 8 * fq;
#pragma unroll
        for (int n = 0; n < 2; ++n) {
            f32x4 w0[2], w1[2], w2[2], bb[2];
#pragma unroll
            for (int bj = 0; bj < 2; ++bj) { const int oc = bj * DFF_ + ocol + 4 * n;
                w0[bj] = *(const f32x4*)(cw + oc); w1[bj] = *(const f32x4*)(cw + 2 * DFF_ + oc); w2[bj] = *(const f32x4*)(cw + 4 * DFF_ + oc); bb[bj] = *(const f32x4*)(cb + oc); }
#pragma unroll
            for (int ai = 0; ai < 2; ++ai) {
                const int ip = wr == 0 ? (ai == 0 ? -1 : 1) : (ai == 0 ? 0 : 2);
                const int in = wr == 0 ? (ai == 0 ? 0 : 2) : (ai == 0 ? 1 : -1);
                f32x4 hp[2], hn[2];
#pragma unroll
                for (int bj = 0; bj < 2; ++bj) { hp[bj] = (f32x4){0.f, 0.f, 0.f, 0.f}; hn[bj] = (f32x4){0.f, 0.f, 0.f, 0.f};
                    if (isctx) { if (ip >= 0) hp[bj] = *(const PG8_LAS f32x4*)(hs + (bj * 3 + ip) * 32 + 8 * fq + 4 * n); if (in >= 0) hn[bj] = *(const PG8_LAS f32x4*)(hs + (bj * 3 + in) * 32 + 8 * fq + 4 * n); } }
#pragma unroll
                for (int m = 0; m < 4; ++m) {
                    f32x4 o[2];
#pragma unroll
                    for (int bj = 0; bj < 2; ++bj) {
                        const f32x4 cur = acc[ai][bj][m][n];
                        const f32x4 offp = (fr == 15 && m > 0) ? acc[ai][bj][m > 0 ? m - 1 : 0][n] : cur;
                        const f32x4 offn = (fr == 0 && m < 3) ? acc[ai][bj][m < 3 ? m + 1 : 3][n] : cur;
                        f32x4 pv, nv;
#pragma unroll
                        for (int e = 0; e < 4; ++e) { pv[e] = __shfl(offp[e], lprev, 64); nv[e] = __shfl(offn[e], lnext, 64); }
                        if (m == 0) pv = fr == 0 ? hp[bj] : pv;
                        if (m == 3) nv = fr == 15 ? hn[bj] : nv;
                        o[bj] = bb[bj] + w0[bj] * pv + w1[bj] * cur + w2[bj] * nv;
                    }
                    float a0 = o[0][0], a1 = o[0][1], a2 = o[0][2], a3 = o[0][3];
                    u32x2 w; w.x = cvt_pk_bf16(a0 * sigm(a0) * o[1][0], a1 * sigm(a1) * o[1][1]); w.y = cvt_pk_bf16(a2 * sigm(a2) * o[1][2], a3 * sigm(a3) * o[1][3]);
                    *(u32x2*)(ACT + (size_t)(row0 + ai * HALF + m * 16) * DFF_ + ocol + 4 * n) = w;
                }
            }
        }
    }
};

template <class Epi, class Sched, bool ALIGN_EPI = false, bool SP2 = false>
__device__ __forceinline__ void gemm_phase(PG8_LAS unsigned char* lds, const Gemm g, const Sched& S, const Epi& E) {
    int tid_ = threadIdx.x; asm volatile("" : "+v"(tid_));
    const int tid = tid_, wid = __builtin_amdgcn_readfirstlane(tid >> 6), lane = tid & 63, wr = wid >> 2, wc = wid & 3, fr = lane & 15, fq = lane >> 4;
    const int K = g.K, nt = K / BK;
    unsigned voffA[2], voffB[2];
#pragma unroll
    for (int i = 0; i < 2; ++i) { int R, C; stage_rc(tid * 16 + i * 8192, R, C); const int Rb = Epi::PERM ? ((R & ~31) + perm32(R & 31)) : R;
        voffA[i] = (unsigned)(R * K + C) * 2u; voffB[i] = (unsigned)(Rb * K + C) * 2u; }
    const size_t kstep = (size_t)(BK * 2);
    const size_t hstep = (size_t)HALF * K * 2;
    const size_t tstep = 2 * hstep;
    const unsigned ldsw = (unsigned)wid * 1024u;
    const int aoff = lds_byte(wr * 64 + fr, fq * 8), boff = lds_byte(wc * 32 + fr, fq * 8);
#define PG8_SA(b, h) (((b) * 2 + (h)) * HTB)
#define PG8_SB(b, h) ((4 + (b) * 2 + (h)) * HTB)
#define PG8_STAGE(bufoff, gbase, voff) do { _Pragma("unroll") for (int _i = 0; _i < 2; ++_i) \
        __builtin_amdgcn_global_load_lds((const unsigned*)((const char*)(gbase) + (voff)[_i]), (PG8_LAS unsigned*)(lds + (bufoff) + ldsw + _i * 8192), 16, 0, 0); } while (0)
#define PG8_LDA(dst, b, h) do { _Pragma("unroll") for (int m = 0; m < 4; ++m) _Pragma("unroll") for (int k = 0; k < 2; ++k) dst[m][k] = *(const PG8_LAS bf16x8*)(lds + PG8_SA(b, h) + aoff + m * 2048 + k * 1024); } while (0)
#define PG8_LDB(dst, b, h) do { _Pragma("unroll") for (int n = 0; n < 2; ++n) _Pragma("unroll") for (int k = 0; k < 2; ++k) dst[n][k] = *(const PG8_LAS bf16x8*)(lds + PG8_SB(b, h) + boff + n * 2048 + k * 1024); } while (0)
#define PG8_MMA(ai, bj, At, Bt) do { __builtin_amdgcn_s_setprio(1); _Pragma("unroll") for (int m = 0; m < 4; ++m) _Pragma("unroll") for (int n = 0; n < 2; ++n) _Pragma("unroll") for (int k = 0; k < 2; ++k) \
        acc[ai][bj][m][n] = __builtin_amdgcn_mfma_f32_16x16x32_bf16(Bt[n][k], At[m][k], acc[ai][bj][m][n], 0, 0, 0); __builtin_amdgcn_s_setprio(0); } while (0)
#define PG8_WAIT_V(n) asm volatile("s_waitcnt vmcnt(" #n ")" ::: "memory")
#define PG8_WAIT_L(n) asm volatile("s_waitcnt lgkmcnt(" #n ")" ::: "memory")
#define PG8_BAR __builtin_amdgcn_s_barrier()
#define PG8_SCHED __builtin_amdgcn_sched_barrier(0)
    Unit cur, nxt; int ui = 0;
    if (!S.next(0, cur)) return;
    f32x4 acc[2][2][4][2];
#pragma unroll
    for (int a = 0; a < 2; ++a)
#pragma unroll
        for (int b = 0; b < 2; ++b)
#pragma unroll
            for (int m = 0; m < 4; ++m)
#pragma unroll
                for (int n = 0; n < 2; ++n) acc[a][b][m][n] = (f32x4){0.f, 0.f, 0.f, 0.f};
    bf16x8 At[4][2], B0[2][2], B1[2][2];
    const char* cA = (const char*)g.A + (size_t)cur.pm * tstep; const char* cB = (const char*)g.Bt + (size_t)cur.pn * tstep;
    S.a_ready(cur);
    if constexpr (SP2) {
        PG8_STAGE(PG8_SB(0, 0), cB, voffB); PG8_STAGE(PG8_SB(0, 1), cB + hstep, voffB); PG8_STAGE(PG8_SA(0, 0), cA, voffA); PG8_STAGE(PG8_SA(0, 1), cA + hstep, voffA);
        if (wr == 1) PG8_BAR;
        PG8_WAIT_V(2); PG8_BAR;
        PG8_STAGE(PG8_SB(1, 0), cB + kstep, voffB); PG8_STAGE(PG8_SA(1, 0), cA + kstep, voffA); PG8_STAGE(PG8_SB(1, 1), cB + hstep + kstep, voffB);
        PG8_WAIT_V(6); PG8_BAR;
    } else {
        PG8_STAGE(PG8_SB(0, 0), cB, voffB); PG8_STAGE(PG8_SA(0, 0), cA, voffA); PG8_STAGE(PG8_SB(0, 1), cB + hstep, voffB); PG8_STAGE(PG8_SA(0, 1), cA + hstep, voffA);
        if (wr == 1) PG8_BAR;
        PG8_WAIT_V(4); PG8_BAR;
        PG8_STAGE(PG8_SB(1, 0), cB + kstep, voffB); PG8_STAGE(PG8_SA(1, 0), cA + kstep, voffA); PG8_STAGE(PG8_SB(1, 1), cB + hstep + kstep, voffB);
        PG8_WAIT_V(6); PG8_BAR;
    }
    for (;;) {
        const bool has_next = S.next(ui + 1, nxt);
        const char* nA = has_next ? (const char*)g.A + (size_t)nxt.pm * tstep : cA; const char* nB = has_next ? (const char*)g.Bt + (size_t)nxt.pn * tstep : cB;
        for (int t = 0; t < nt; t += 2) {
            const bool last = (t == nt - 2);
            const char* a1 = cA + (size_t)(t + 1) * kstep;
            const char* a2 = last ? nA : cA + (size_t)(t + 2) * kstep; const char* b2 = last ? nB : cB + (size_t)(t + 2) * kstep;
            const char* a3 = a2 + kstep; const char* b3 = b2 + kstep;
            if (last && has_next) S.a_ready(nxt);
            if constexpr (SP2) {
            PG8_LDB(B0, 0, 0); PG8_LDB(B1, 0, 1); PG8_SCHED; PG8_LDA(At, 0, 0); PG8_STAGE(PG8_SA(1, 1), a1 + hstep, voffA);
            PG8_WAIT_V(8); PG8_WAIT_L(0); PG8_BAR; PG8_MMA(0, 0, At, B0); PG8_MMA(0, 1, At, B1); PG8_BAR; PG8_SCHED;
            PG8_LDA(At, 0, 1); PG8_STAGE(PG8_SB(0, 0), b2, voffB); PG8_STAGE(PG8_SB(0, 1), b2 + hstep, voffB); PG8_STAGE(PG8_SA(0, 0), a2, voffA);
            PG8_WAIT_V(8); PG8_WAIT_L(0); PG8_BAR; PG8_MMA(1, 0, At, B0); PG8_MMA(1, 1, At, B1); PG8_BAR; PG8_SCHED;
            PG8_LDB(B0, 1, 0); PG8_LDB(B1, 1, 1); PG8_SCHED; PG8_LDA(At, 1, 0); PG8_STAGE(PG8_SA(0, 1), a2 + hstep, voffA);
            PG8_WAIT_V(8); PG8_WAIT_L(0); PG8_BAR; PG8_MMA(0, 0, At, B0); PG8_MMA(0, 1, At, B1); PG8_BAR; PG8_SCHED;
            PG8_LDA(At, 1, 1); PG8_STAGE(PG8_SB(1, 0), b3, voffB); PG8_STAGE(PG8_SB(1, 1), b3 + hstep, voffB); PG8_STAGE(PG8_SA(1, 0), a3, voffA);
            PG8_WAIT_V(8); PG8_WAIT_L(0); PG8_BAR; PG8_MMA(1, 0, At, B0); PG8_MMA(1, 1, At, B1); PG8_BAR; PG8_SCHED;
            } else {
            PG8_LDB(B0, 0, 0); PG8_SCHED; PG8_LDA(At, 0, 0); PG8_STAGE(PG8_SA(1, 1), a1 + hstep, voffA);
            PG8_WAIT_L(8); PG8_BAR; PG8_WAIT_L(0); PG8_MMA(0, 0, At, B0); PG8_BAR; PG8_SCHED;
            PG8_LDB(B1, 0, 1); PG8_STAGE(PG8_SB(0, 0), b2, voffB);
            PG8_BAR; PG8_WAIT_L(0); PG8_MMA(0, 1, At, B1); PG8_BAR;
            PG8_LDA(At, 0, 1); PG8_STAGE(PG8_SA(0, 0), a2, voffA);
            PG8_BAR; PG8_WAIT_L(0); PG8_MMA(1, 0, At, B0); PG8_BAR; PG8_SCHED;
            PG8_STAGE(PG8_SB(0, 1), b2 + hstep, voffB);
            PG8_WAIT_V(6); PG8_BAR; PG8_MMA(1, 1, At, B1); PG8_BAR;
            PG8_LDB(B0, 1, 0); PG8_SCHED; PG8_LDA(At, 1, 0); PG8_STAGE(PG8_SA(0, 1), a2 + hstep, voffA);
            PG8_WAIT_L(8); PG8_BAR; PG8_WAIT_L(0); PG8_MMA(0, 0, At, B0); PG8_BAR; PG8_SCHED;
            PG8_LDB(B1, 1, 1); PG8_STAGE(PG8_SB(1, 0), b3, voffB);
            PG8_BAR; PG8_WAIT_L(0); PG8_MMA(0, 1, At, B1); PG8_BAR;
            PG8_LDA(At, 1, 1); PG8_STAGE(PG8_SA(1, 0), a3, voffA);
            PG8_BAR; PG8_WAIT_L(0); PG8_MMA(1, 0, At, B0); PG8_BAR; PG8_SCHED;
            PG8_STAGE(PG8_SB(1, 1), b3 + hstep, voffB);
            PG8_WAIT_V(6); PG8_BAR; PG8_MMA(1, 1, At, B1); PG8_BAR;
            }
        }
        if constexpr (ALIGN_EPI) { if (wr == 0) PG8_BAR; }
        if constexpr (!Epi::AFTER_DRAIN) { E(acc, cur, wr, wc, fr, fq); S.done(cur); }
        if (!has_next) break;
#pragma unroll
        for (int a = 0; a < 2; ++a)
#pragma unroll
            for (int b = 0; b < 2; ++b)
#pragma unroll
                for (int m = 0; m < 4; ++m)
#pragma unroll
                    for (int n = 0; n < 2; ++n) acc[a][b][m][n] = (f32x4){0.f, 0.f, 0.f, 0.f};
        cur = nxt; cA = nA; cB = nB; ++ui;
        if constexpr (ALIGN_EPI) { if (wr == 1) PG8_BAR; }
    }
    PG8_WAIT_V(0);
    if constexpr (!ALIGN_EPI) { if (wr == 0) PG8_BAR; }
    PG8_BAR;
    if constexpr (Epi::AFTER_DRAIN) { E.fused(acc, cur, wr, wc, fr, fq, lds, wid, lane); S.done(cur); }
#undef PG8_SA
#undef PG8_SB
#undef PG8_STAGE
#undef PG8_LDA
#undef PG8_LDB
#undef PG8_MMA
#undef PG8_WAIT_V
#undef PG8_WAIT_L
#undef PG8_BAR
#undef PG8_SCHED
}
}

#define GAS __attribute__((address_space(1)))
#define LAS __attribute__((address_space(3)))
typedef float f32x4 __attribute__((ext_vector_type(4)));
typedef unsigned u32x2 __attribute__((ext_vector_type(2)));
typedef unsigned u32x4 __attribute__((ext_vector_type(4)));
constexpr int NT = 512;
constexpr int LDS_BYTES = 147456;
constexpr int RING_BYTES = 131072, LDSCTL_OFF = RING_BYTES, MISC_OFF = LDSCTL_OFF + 320, HALO_OFF = 132096;
static_assert(HALO_OFF + 8 * 768 <= LDS_BYTES && MISC_OFF + 128 <= HALO_OFF, "LDS map");
#define XB_TMO      128
#define XB_XCNT(j)  (256  + 64 * (j))
#define XB_XSUB(j)  (1280 + 64 * (j))
#define XB_XGEN(j)  (2304 + 64 * (j))
#define XB_TOP      3328
#define XB_TOPGEN   3392
#define XCD_BAR_WORDS 3456
#define XB_SPIN_CAP (1u << 18)

__device__ __forceinline__ unsigned xb_ld(unsigned* p)              { return __hip_atomic_load(p, __ATOMIC_RELAXED, __HIP_MEMORY_SCOPE_AGENT); }
__device__ __forceinline__ unsigned xb_add(unsigned* p, unsigned v) { return __hip_atomic_fetch_add(p, v, __ATOMIC_RELAXED, __HIP_MEMORY_SCOPE_AGENT); }
__device__ __forceinline__ unsigned xb_xcc_id() { return (unsigned)__builtin_amdgcn_s_getreg((3 << 11) | 20) & 0xFu; }
#define XB_SPIN(cond, bar) do { unsigned _sp = 0; while (cond) { __builtin_amdgcn_s_sleep(1); \
    if ((++_sp & 255u) == 0u) { if (xb_ld(&(bar)[XB_TMO])) break; if (_sp > XB_SPIN_CAP) { atomicAdd(&(bar)[XB_TMO], 1u); break; } } } } while (0)

struct XcdBarrier {
    unsigned* bar; unsigned x;
    volatile LAS unsigned* st;
};

__device__ __forceinline__ XcdBarrier xcd_barrier_post(unsigned* bar, volatile LAS unsigned* st) {
    XcdBarrier b; b.bar = bar; b.x = xb_xcc_id(); b.st = st;
    if (threadIdx.x == 0) (void)xb_add(&bar[XB_XCNT(b.x)], 1u);
    return b;
}
__device__ __forceinline__ void xcd_barrier_complete(unsigned* bar, unsigned x, unsigned& nloc, unsigned& nx) {
    const unsigned G = gridDim.x * gridDim.y * gridDim.z;
    unsigned sum, cnt, mine, sp = 0u;
    for (;;) {
        sum = 0u; cnt = 0u; mine = 0u;
#pragma unroll
        for (unsigned j = 0; j < 16; ++j) { const unsigned c = xb_ld(&bar[XB_XCNT(j)]); sum += c; cnt += (c > 0u) ? 1u : 0u; mine = (j == x) ? c : mine; }
        if (sum == G) break;
        __builtin_amdgcn_s_sleep(1);
        if ((++sp & 255u) == 0u) { if (xb_ld(&bar[XB_TMO])) break; if (sp > XB_SPIN_CAP) { atomicAdd(&bar[XB_TMO], 1u); break; } }
    }
    nloc = mine > 0u ? mine : 1u; nx = cnt > 0u ? cnt : 1u;
}

__device__ __forceinline__ void xcd_barrier(const XcdBarrier& b) {
    asm volatile("s_waitcnt vmcnt(0)" ::: "memory");
    __syncthreads();
    if (threadIdx.x == 0) {
        unsigned* bar = b.bar; const unsigned bx_ = (unsigned)__builtin_amdgcn_readfirstlane((int)xb_xcc_id());
        __builtin_amdgcn_s_waitcnt(0);
        unsigned nloc = b.st[0], nx = b.st[1];
        if (nloc == 0u) { xcd_barrier_complete(bar, bx_, nloc, nx); b.st[0] = nloc; b.st[1] = nx; }
        const unsigned old = xb_add(&bar[XB_XSUB(bx_)], 1u);
        const unsigned gen = old / nloc;
        if (old + 1u == (gen + 1u) * nloc) {
            __builtin_amdgcn_fence(__ATOMIC_RELEASE, "agent");
            asm volatile("s_waitcnt vmcnt(0)" ::: "memory");
            const unsigned og = xb_add(&bar[XB_TOP], 1u);
            const unsigned tg = og / nx;
            if (og + 1u == (tg + 1u) * nx) xb_add(&bar[XB_TOPGEN], 1u);
            else XB_SPIN(xb_ld(&bar[XB_TOPGEN]) == tg, bar);
            __builtin_amdgcn_fence(__ATOMIC_ACQUIRE, "agent");
            xb_add(&bar[XB_XGEN(bx_)], 1u);
            asm volatile("s_waitcnt vmcnt(0)" ::: "memory");
        } else {
            XB_SPIN(xb_ld(&bar[XB_XGEN(bx_)]) == gen, bar);
            __builtin_amdgcn_fence(__ATOMIC_ACQUIRE, "agent");
            asm volatile("s_waitcnt vmcnt(0)" ::: "memory");
        }
    }
    __syncthreads();
}

constexpr size_t MiB = 1u << 20;
constexpr size_t WS_CTL = 0, CTL_ZERO_BYTES = 64 * 1024, WS_MISC = 1 * MiB, WS_XC = 5 * MiB, WS_WIN = 9 * MiB, WS_WGLU = 33 * MiB, WS_WOUT = 35 * MiB, WS_WUP = 43 * MiB, WS_WDN = 87 * MiB,
                 WS_H = 109 * MiB, WS_P = 143 * MiB, WS_YFB = 245 * MiB, WS_OFB = 279 * MiB, WS_S5Y = 313 * MiB, WS_Y = 330 * MiB, WS_END = 364 * MiB;
constexpr size_t WS_ACT = WS_P;
static_assert((size_t)M * INC * 2 <= 102 * MiB && (size_t)M * D * 2 <= 34 * MiB && (size_t)M * DFF * 2 <= 102 * MiB, "ws map");
constexpr int CW_BAR = 1024;
static_assert((CW_BAR + XCD_BAR_WORDS) * 4 <= (int)CTL_ZERO_BYTES, "ctl");

struct Args { const float* in[N_IN]; float* out; unsigned char* ws; int pad0, pad1; };
struct Bufs {
    float *MOD, *LB, *AB, *BB, *XC; bf16 *WIN, *WGLU, *WOUT, *WUP, *WDN, *H, *P, *ACT, *YF, *YB, *OF, *OB, *S5Y, *Y;
};
__device__ __forceinline__ float* xrow_ptr(float* xc, float* xo, int r) { return r < MC ? xc + (size_t)r * D : xo + (size_t)(r - MC) * D; }
__device__ __forceinline__ float wave_sum(float v) {
#pragma unroll
    for (int o = 1; o < 64; o <<= 1) v += __shfl_xor(v, o);
    return v;
}
__device__ __forceinline__ unsigned pk2(float lo, float hi) { return (unsigned)f2bf(lo) | ((unsigned)f2bf(hi) << 16); }

#define TIDX tid_fresh()
__device__ __forceinline__ int tid_fresh() { int t = threadIdx.x; asm volatile("" : "+v"(t)); return t; }
__device__ __forceinline__ void p_mod(const Args& a, const Bufs& B, LAS unsigned char* lds, int vcu, int G) {
    LAS float* sc = (LAS float*)lds;
    LAS float* part = sc + 5 * 1024;
    const int tid = TIDX;
    for (int i = tid; i < 5 * 1024; i += NT) { const int r = i >> 10, k = i & 1023; const float c = r < 4 ? a.in[I_C][r * D + k] : a.in[I_CCTX][k]; sc[i] = siluf_(c); }
    __syncthreads();
    const int kq = tid >> 7, jc = tid & 127;
    for (int it = vcu; it < DEPTH * 48; it += G) {
        const int l = it / 48, j0 = (it % 48) * 128;
        const float* w = a.in[I_WMOD] + (size_t)l * D * 6 * D + (size_t)(kq * 256) * 6 * D + j0 + jc;
        float acc[5] = {0.f, 0.f, 0.f, 0.f, 0.f};
#pragma unroll 8
        for (int k = 0; k < 256; ++k) { const float wv = w[(size_t)k * 6 * D];
#pragma unroll
            for (int r = 0; r < 5; ++r) acc[r] += sc[r * 1024 + kq * 256 + k] * wv; }
#pragma unroll
        for (int r = 0; r < 5; ++r) part[(kq * 5 + r) * 128 + jc] = acc[r];
        __syncthreads();
        if (kq == 0) {
#pragma unroll
            for (int r = 0; r < 5; ++r) B.MOD[((size_t)l * 5 + r) * 6 * D + j0 + jc] = a.in[I_BMOD][l * 6 * D + j0 + jc] + part[r * 128 + jc] + part[(5 + r) * 128 + jc] + part[(10 + r) * 128 + jc] + part[(15 + r) * 128 + jc];
        }
        __syncthreads();
    }
}
__device__ __forceinline__ void p_small(const Args& a, const Bufs& B, int vcu, int G) {
    const int gt = vcu * NT + TIDX, NGT = G * NT;
    for (int idx = gt; idx < 2 * HGW; idx += NGT) {
        float v[DEPTH], mx = -1e30f;
#pragma unroll
        for (int l = 0; l < DEPTH; ++l) { v[l] = a.in[I_HGLB][l * 2 * HGW + idx]; mx = fmaxf(mx, v[l]); }
        float s = 0.f;
#pragma unroll
        for (int l = 0; l < DEPTH; ++l) { v[l] = __expf(v[l] - mx); s += v[l]; }
        float cum = 0.f, first = 0.f;
#pragma unroll
        for (int l = 0; l < DEPTH; ++l) { cum += v[l] / s; if (l == 0) first = cum; B.LB[l * 2 * HGW + idx] = cum - first; }
    }
    for (int idx = gt; idx < DEPTH * 2 * S5G * S5P; idx += NGT) {
        const int ldg = idx / S5P;
        const float lr = a.in[I_LRE][idx], li = a.in[I_LIM][idx], dt = expf(a.in[I_LDT][ldg]);
        const float mag = expf(lr * dt), ang = li * dt;
        const float ar = mag * cosf(ang), ai = mag * sinf(ang);
        B.AB[idx * 2] = ar; B.AB[idx * 2 + 1] = ai;
        const float den = lr * lr + li * li, nr = ar - 1.f, ni = ai;
        const float cr = (nr * lr + ni * li) / den, ci = (ni * lr - nr * li) / den;
        for (int h = 0; h < S5H; ++h) {
            const float br = a.in[I_BRE][(size_t)idx * S5H + h], bi = a.in[I_BIM][(size_t)idx * S5H + h];
            B.BB[((size_t)idx * S5H + h) * 2] = cr * br - ci * bi; B.BB[((size_t)idx * S5H + h) * 2 + 1] = cr * bi + ci * br;
        }
    }
    { const f32x4* s = (const f32x4*)a.in[I_X]; f32x4* d = (f32x4*)a.out; for (size_t i = gt; i < (size_t)MX * D / 4; i += NGT) d[i] = s[i]; }
    { const f32x4* s = (const f32x4*)a.in[I_CTX]; f32x4* d = (f32x4*)B.XC; for (size_t i = gt; i < (size_t)MC * D / 4; i += NGT) d[i] = s[i]; }
}
__device__ __forceinline__ void wprep_tile(const float* W, bf16* Wt, int K, int N, int mode, int tn, int tk, LAS float* tile, int t256) {
    const int n0 = tn * 64, k0 = tk * 64, tx = t256 & 63, ty = t256 >> 6;
    const int np = n0 + tx; const int nsrc = mode == 1 ? (((np & 255) < 128 ? 0 : DFF) + 128 * (np >> 8) + (np & 127)) : np;
    for (int i = ty; i < 64; i += 4) tile[i * 65 + tx] = W[(size_t)(k0 + i) * N + nsrc];
    __syncthreads();
    for (int i = ty; i < 64; i += 4) Wt[(size_t)(n0 + i) * K + k0 + tx] = f2bf(tile[tx * 65 + i]);
    __syncthreads();
}
__device__ __forceinline__ void p_wprep(const Args& a, const Bufs& B, LAS unsigned char* lds, int vcu, int G) {
    constexpr int T_IN = 768, T_GLU = 64, T_OUT = 256, T_UP = 1408, T_DN = 704, T_L = T_IN + T_GLU + T_OUT + T_UP + T_DN;
    const int half = TIDX >> 8, t256 = TIDX & 255;
    LAS float* tile = (LAS float*)lds + half * (64 * 65);
    for (int it = vcu; it < DEPTH * T_L / 2; it += G) {
        const int item = it * 2 + half; const int l = item / T_L; int r = item % T_L;
        if (r < T_IN) { wprep_tile(a.in[I_WIN] + (size_t)l * D * INC, B.WIN + (size_t)l * INC * D, D, INC, 0, r % 48, r / 48, tile, t256); continue; } r -= T_IN;
        if (r < T_GLU) { wprep_tile(a.in[I_WGLU] + (size_t)l * S5W * S5W, B.WGLU + (size_t)l * S5W * S5W, S5W, S5W, 0, r % 8, r / 8, tile, t256); continue; } r -= T_GLU;
        if (r < T_OUT) { wprep_tile(a.in[I_WOUT] + (size_t)l * D * D, B.WOUT + (size_t)l * D * D, D, D, 0, r % 16, r / 16, tile, t256); continue; } r -= T_OUT;
        if (r < T_UP) { wprep_tile(a.in[I_WUP] + (size_t)l * D * 2 * DFF, B.WUP + (size_t)l * 2 * DFF * D, D, 2 * DFF, 1, r % 88, r / 88, tile, t256); continue; } r -= T_UP;
        wprep_tile(a.in[I_WDOWN] + (size_t)l * DFF * D, B.WDN + (size_t)l * D * DFF, DFF, D, 0, r % 16, r / 16, tile, t256);
    }
}
__device__ __forceinline__ void p_modulate(const Args& a, const Bufs& B, const float* modl, int off_sh, int off_sc, int vcu, int G) {
    const int lane = TIDX & 63, gw = vcu * 8 + (TIDX >> 6), NGW = G * 8;
    for (int r = gw; r < M; r += NGW) {
        const f32x4* x = (const f32x4*)xrow_ptr(B.XC, a.out, r) + lane; const float* mr = modl + (size_t)row_modidx(r) * 6 * D;
        u32x2* o = (u32x2*)(B.H + (size_t)r * D) + lane;
#pragma unroll
        for (int j = 0; j < 4; ++j) { const f32x4 v = x[64 * j], sc = *((const f32x4*)(mr + off_sc) + lane + 64 * j), sh = *((const f32x4*)(mr + off_sh) + lane + 64 * j);
            u32x2 w; w.x = pk2(v[0] * (1.f + sc[0]) + sh[0], v[1] * (1.f + sc[1]) + sh[1]); w.y = pk2(v[2] * (1.f + sc[2]) + sh[2], v[3] * (1.f + sc[3]) + sh[3]); o[64 * j] = w; }
    }
}
__device__ __forceinline__ void p_ln(const Args& a, const Bufs& B, const float* lg, const float* lbv, const float* modn, int off_sh, int off_sc, int vcu, int G) {
    const int lane = TIDX & 63, gw = vcu * 8 + (TIDX >> 6), NGW = G * 8;
    for (int r = gw; r < M; r += NGW) {
        f32x4* x = (f32x4*)xrow_ptr(B.XC, a.out, r) + lane;
        f32x4 v[4]; float s = 0.f;
#pragma unroll
        for (int j = 0; j < 4; ++j) { v[j] = x[64 * j]; s += (v[j][0] + v[j][1]) + (v[j][2] + v[j][3]); }
        const float mean = wave_sum(s) * (1.f / D); float q = 0.f;
#pragma unroll
        for (int j = 0; j < 4; ++j) { v[j] = v[j] - mean; q += (v[j][0] * v[j][0] + v[j][1] * v[j][1]) + (v[j][2] * v[j][2] + v[j][3] * v[j][3]); }
        const float rstd = rsqrtf(wave_sum(q) * (1.f / D) + LN_EPS);
        const float* mr = modn ? modn + (size_t)row_modidx(r) * 6 * D : nullptr;
        u32x2* o = (u32x2*)(B.H + (size_t)r * D) + lane;
#pragma unroll
        for (int j = 0; j < 4; ++j) { const f32x4 g = *((const f32x4*)lg + lane + 64 * j), bb = *((const f32x4*)lbv + lane + 64 * j); const f32x4 y = v[j] * rstd * g + bb; x[64 * j] = y;
            if (mr) { const f32x4 sc = *((const f32x4*)(mr + off_sc) + lane + 64 * j), sh = *((const f32x4*)(mr + off_sh) + lane + 64 * j);
                u32x2 w; w.x = pk2(y[0] * (1.f + sc[0]) + sh[0], y[1] * (1.f + sc[1]) + sh[1]); w.y = pk2(y[2] * (1.f + sc[2]) + sh[2], y[3] * (1.f + sc[3]) + sh[3]); o[64 * j] = w; } }
    }
}

__device__ __forceinline__ int s5_row(int b, int d, int s) {
    if (s < CTX) { const int t = d ? CTX - 1 - s : s; return b * CTX + t; }
    const int t = d ? SEQ - 1 - (s - CTX) : (s - CTX); return MC + b * SEQ + t;
}
__device__ __forceinline__ void p_s5_naive(const Args& a, const Bufs& B, int l, LAS unsigned char* lds, int vcu, int G) {
    LAS float* xs = (LAS float*)lds;
    LAS float* cs = xs + 16 * 128;
    const float* abl = B.AB + (size_t)l * 2 * S5G * S5P * 2; const float* bbl = B.BB + (size_t)l * 2 * S5G * S5P * S5H * 2;
    const float* crel = a.in[I_CRE] + (size_t)l * 2 * S5G * S5H * S5P; const float* ciml = a.in[I_CIM] + (size_t)l * 2 * S5G * S5H * S5P;
    const int p = TIDX & 63; const bool w0 = TIDX < 64;
    for (int task = vcu; task < BATCH * S5G * 2; task += G) {
        const int b = task / (S5G * 2), g = (task / 2) % S5G, d = task & 1;
        const int dgp = (d * S5G + g) * S5P + p;
        const float ar = abl[dgp * 2], ai = abl[dgp * 2 + 1];
        float br[16], bi[16];
#pragma unroll
        for (int h = 0; h < 16; ++h) { br[h] = bbl[((size_t)dgp * 16 + h) * 2]; bi[h] = bbl[((size_t)dgp * 16 + h) * 2 + 1]; }
        if (w0) for (int h = 0; h < 16; ++h) { cs[h * 128 + p] = crel[((size_t)(d * S5G + g) * S5H + h) * S5P + p]; cs[h * 128 + 64 + p] = ciml[((size_t)(d * S5G + g) * S5H + h) * S5P + p]; }
        bf16* Y = d ? B.YB : B.YF;
        float xr = 0.f, xi = 0.f;
        for (int s0 = 0; s0 < CTX + SEQ; s0 += 16) {
            if (w0) {
#pragma unroll 4
                for (int i = 0; i < 16; ++i) {
                    const int row = s5_row(b, d, s0 + i);
                    const bf16* u = B.P + (size_t)row * INC + g * 16;
                    float sr = 0.f, si = 0.f;
#pragma unroll
                    for (int h = 0; h < 16; ++h) { const float uv = bf2f(u[h]); sr += br[h] * uv; si += bi[h] * uv; }
                    const float nr = ar * xr - ai * xi + sr, ni = ar * xi + ai * xr + si;
                    xr = nr; xi = ni;
                    xs[i * 128 + p] = xr; xs[i * 128 + 64 + p] = xi;
                }
            }
            __syncthreads();
            if (w0) { const int t = p >> 2, h0 = (p & 3) * 4; const int row = s5_row(b, d, s0 + t);
#pragma unroll
                for (int hh = 0; hh < 4; ++hh) { const int h = h0 + hh; float acc = 0.f;
                    for (int q = 0; q < 64; ++q) acc += xs[t * 128 + q] * cs[h * 128 + q] - xs[t * 128 + 64 + q] * cs[h * 128 + 64 + q];
                    Y[(size_t)row * S5W + g * 16 + h] = f2bf(acc); } }
            __syncthreads();
        }
    }
}
__device__ __forceinline__ void p_gla_naive(const Args& a, const Bufs& B, int l, LAS unsigned char* lds, int vcu, int G) {
    LAS float* fs = (LAS float*)lds; LAS float* ks = fs + 128; LAS float* qs = ks + 128;
    const float* lbl = B.LB + (size_t)l * 2 * HGW;
    const int v = TIDX & 127; const bool act = TIDX < 128;
    for (int task = vcu; task < BATCH * NH * 2; task += G) {
        const int b = task / (NH * 2), hd = (task / 2) % NH, d = task & 1;
        float S[128];
#pragma unroll
        for (int k = 0; k < 128; ++k) S[k] = 0.f;
        const float lbv = lbl[d * HGW + hd * HD + v];
        bf16* O = d ? B.OB : B.OF;
        for (int s = 0; s < CTX + SEQ; ++s) {
            const int row = s5_row(b, d, s);
            const bf16* pr = B.P + (size_t)row * INC;
            float vv = 0.f;
            if (act) { const float fr = bf2f(pr[512 + d * 512 + hd * HD + v]); const float f = lbv + (1.f - lbv) * sigmoidf_(fr);
                fs[v] = f; ks[v] = 1.f - f; qs[v] = siluf_(bf2f(pr[2048 + hd * HD + v])); vv = bf2f(pr[1536 + hd * HD + v]); }
            __syncthreads();
            if (act) { float o = 0.f;
#pragma unroll
                for (int k = 0; k < 128; ++k) { S[k] = fs[k] * S[k] + ks[k] * vv; o += S[k] * qs[k]; }
                O[(size_t)row * HGW + hd * HD + v] = f2bf(o); }
            __syncthreads();
        }
    }
}
__device__ __forceinline__ void p_mixout(const Args& a, const Bufs& B, int l, LAS unsigned char* lds, int vcu, int G) {
    LAS float* red = (LAS float*)lds;
    const float* sd = a.in[I_SD] + (size_t)l * S5W; const float* nw = a.in[I_HGNW] + (size_t)l * HD;
    const int c = TIDX;
    for (int r = vcu; r < M; r += G) {
        const bf16* pr = B.P + (size_t)r * INC;
        const float y = bf2f(B.YF[(size_t)r * S5W + c]) + bf2f(B.YB[(size_t)r * S5W + c]) + bf2f(pr[c]) * sd[c];
        B.S5Y[(size_t)r * S5W + c] = f2bf(gelu_tanh(y));
        const float o = bf2f(B.OF[(size_t)r * HGW + c]) + bf2f(B.OB[(size_t)r * HGW + c]);
        float s = o * o;
        for (int off = 32; off >= 1; off >>= 1) s += __shfl_xor(s, off);
        if ((c & 63) == 0) red[c >> 6] = s;
        __syncthreads();
        const float ms = (red[(c >> 7) * 2] + red[(c >> 7) * 2 + 1]) * (1.f / 128.f);
        const float g = bf2f(pr[2560 + c]);
        B.Y[(size_t)r * D + 512 + c] = f2bf(o * rsqrtf(ms + RMS_EPS) * nw[c & 127] * siluf_(g));
        __syncthreads();
    }
}

#undef TIDX
__global__ void __launch_bounds__(NT, 2) mk_fwd(Args args) {
    extern __shared__ __attribute__((aligned(16))) unsigned char lds_raw[];
    LAS unsigned char* lds = (LAS unsigned char*)lds_raw;
    volatile LAS unsigned* MISC = (volatile LAS unsigned*)(lds + MISC_OFF);
    const int G = gridDim.x; const int bx = blockIdx.x; const int vcu = (G % 8 == 0) ? (bx % 8) * (G / 8) + bx / 8 : bx;
    unsigned char* ws = args.ws;
    Bufs B;
    B.MOD = (float*)(ws + WS_MISC); B.LB = B.MOD + DEPTH * 5 * 6 * D; B.AB = B.LB + DEPTH * 2 * HGW; B.BB = B.AB + DEPTH * 2 * S5G * S5P * 2;
    B.XC = (float*)(ws + WS_XC);
    B.WIN = (bf16*)(ws + WS_WIN); B.WGLU = (bf16*)(ws + WS_WGLU); B.WOUT = (bf16*)(ws + WS_WOUT); B.WUP = (bf16*)(ws + WS_WUP); B.WDN = (bf16*)(ws + WS_WDN);
    B.H = (bf16*)(ws + WS_H); B.P = (bf16*)(ws + WS_P); B.ACT = (bf16*)(ws + WS_ACT);
    B.YF = (bf16*)(ws + WS_YFB); B.YB = B.YF + (size_t)M * S5W; B.OF = (bf16*)(ws + WS_OFB); B.OB = B.OF + (size_t)M * HGW;
    B.S5Y = (bf16*)(ws + WS_S5Y); B.Y = (bf16*)(ws + WS_Y);
    for (int u = threadIdx.x; u < (HALO_OFF - LDSCTL_OFF) / 4; u += NT) ((LAS unsigned*)(lds + LDSCTL_OFF))[u] = 0u;
    __syncthreads();
    XcdBarrier bar = xcd_barrier_post((unsigned*)(ws + WS_CTL) + CW_BAR, MISC + 8);
#define GRID_BAR() xcd_barrier(bar)

    p_mod(args, B, lds, vcu, G);
    p_small(args, B, vcu, G);
    p_wprep(args, B, lds, vcu, G);
    GRID_BAR();
    p_modulate(args, B, B.MOD, 0, D, vcu, G);
    GRID_BAR();
    for (int l = 0; l < DEPTH; ++l) {
        const float* modl = B.MOD + (size_t)l * 5 * 6 * D;
        { pg8::Gemm g{B.H, B.WIN + (size_t)l * INC * D, M, INC, D}; pg8::StaticOrder S; S.init(M, INC, G, bx); pg8::EpiBf16Plain E{B.P, INC};
          pg8::gemm_phase<pg8::EpiBf16Plain, pg8::StaticOrder, true, true>(lds, g, S, E); }
        GRID_BAR();
        p_s5_naive(args, B, l, lds, vcu, G);
        p_gla_naive(args, B, l, lds, vcu, G);
        GRID_BAR();
        p_mixout(args, B, l, lds, vcu, G);
        GRID_BAR();
        { pg8::Gemm g{B.S5Y, B.WGLU + (size_t)l * S5W * S5W, M, S5W, S5W}; pg8::StaticOrder S; S.init(M, S5W, G, bx); pg8::EpiGlu E{B.Y, B.S5Y, args.in[I_BGLU] + (size_t)l * S5W};
          pg8::gemm_phase<pg8::EpiGlu, pg8::StaticOrder, true, true>(lds, g, S, E); }
        GRID_BAR();
        { pg8::Gemm g{B.Y, B.WOUT + (size_t)l * D * D, M, D, D}; pg8::StaticOrder S; S.init(M, D, G, bx); pg8::EpiResid E{B.XC, args.out, modl, 2 * D};
          pg8::gemm_phase<pg8::EpiResid, pg8::StaticOrder, true, true>(lds, g, S, E); }
        GRID_BAR();
        p_ln(args, B, args.in[I_LN1G] + (size_t)l * D, args.in[I_LN1B] + (size_t)l * D, modl, 3 * D, 4 * D, vcu, G);
        GRID_BAR();
        { pg8::Gemm g{B.H, B.WUP + (size_t)l * 2 * DFF * D, M, 2 * DFF, D}; pg8::StaticOrder S; S.init(M, 2 * DFF, G, bx);
          pg8::EpiUpConv E{B.ACT, args.in[I_CONVW] + (size_t)l * 3 * 2 * DFF, args.in[I_CONVB] + (size_t)l * 2 * DFF, B.H, B.WUP + (size_t)l * 2 * DFF * D, (LAS float*)(lds + HALO_OFF)};
          pg8::gemm_phase<pg8::EpiUpConv, pg8::StaticOrder, true, true>(lds, g, S, E); }
        GRID_BAR();
        { pg8::Gemm g{B.ACT, B.WDN + (size_t)l * D * DFF, M, D, DFF}; pg8::StaticOrder S; S.init(M, D, G, bx); pg8::EpiResid E{B.XC, args.out, modl, 5 * D};
          pg8::gemm_phase<pg8::EpiResid, pg8::StaticOrder, true, true>(lds, g, S, E); }
        GRID_BAR();
        p_ln(args, B, args.in[I_LN2G] + (size_t)l * D, args.in[I_LN2B] + (size_t)l * D, l + 1 < DEPTH ? modl + 5 * 6 * D : nullptr, 0, D, vcu, G);
        if (l + 1 < DEPTH) GRID_BAR();
    }
}

extern "C" void kernel_launch(void* const* d_in, const int* in_sizes, int n_in, void* d_out, int out_size, void* d_ws, size_t ws_size, hipStream_t stream) {
    static int grid = 0;
    if (grid == 0) {
        if (n_in != N_IN || out_size != MX * D || ws_size < WS_END) { fprintf(stderr, "kernel_launch: unexpected shapes (n_in %d out %d ws %zu)\n", n_in, out_size, ws_size); grid = -1; return; }
        int dev = 0, cus = 0, per_cu = 0;
        if (hipGetDevice(&dev) != hipSuccess || hipDeviceGetAttribute(&cus, hipDeviceAttributeMultiprocessorCount, dev) != hipSuccess) { grid = -1; return; }
        if (hipFuncSetAttribute((const void*)mk_fwd, hipFuncAttributeMaxDynamicSharedMemorySize, LDS_BYTES) != hipSuccess) { fprintf(stderr, "kernel_launch: hipFuncSetAttribute failed\n"); grid = -1; return; }
        if (hipOccupancyMaxActiveBlocksPerMultiprocessor(&per_cu, (const void*)mk_fwd, NT, LDS_BYTES) != hipSuccess || per_cu < 1) { fprintf(stderr, "kernel_launch: occupancy query says %d blocks/CU\n", per_cu); per_cu = 1; }
        (void)hipGetLastError();
        grid = cus;
    }
    if (grid < 0) return;
    if (hipMemsetAsync((char*)d_ws + WS_CTL, 0, CTL_ZERO_BYTES, stream) != hipSuccess) return;
    Args a{};
    for (int i = 0; i < N_IN; ++i) a.in[i] = (const float*)d_in[i];
    a.out = (float*)d_out; a.ws = (unsigned char*)d_ws;
    hipLaunchKernelGGL(mk_fwd, dim3(grid), dim3(NT), LDS_BYTES, stream, a);
}
```

```cpp
#include <hip/hip_runtime.h>
#include <cstdio>
#include <cstdint>

constexpr int D = 1024, BATCH = 4, SEQ = 4096, DEPTH = 4, CTX = 256;
constexpr int S5W = 512, S5G = 32, S5H = 16, S5P = 64, HGW = 512, HD = 128, NH = 4;
constexpr int DFF = 2816, INC = 3072;
constexpr int MC = BATCH * CTX;
constexpr int MX = BATCH * SEQ;
constexpr int M = MC + MX;
constexpr float ALPHA = 1.681792830507429f;
constexpr float LN_EPS = 1e-5f, RMS_EPS = 1e-6f;

enum { I_X = 0, I_C, I_CTX, I_CCTX, I_WMOD, I_BMOD, I_WIN, I_LRE, I_LIM, I_LDT, I_BRE, I_BIM, I_CRE, I_CIM, I_SD, I_WGLU, I_BGLU,
       I_HGLB, I_HGNW, I_WOUT, I_LN1G, I_LN1B, I_WUP, I_CONVW, I_CONVB, I_WDOWN, I_LN2G, I_LN2B, N_IN };

typedef unsigned short bf16;
__device__ __forceinline__ float sigmoidf_(float x) { return 1.f / (1.f + __expf(-x)); }
__device__ __forceinline__ float siluf_(float x) { return x / (1.f + __expf(-x)); }
__device__ __forceinline__ float gelu_tanh(float x) { const float u = 0.7978845608028654f * (x + 0.044715f * x * x * x); return 0.5f * x * (1.f + tanhf(u)); }
__device__ __forceinline__ float bf2f(bf16 b) { return __uint_as_float(((unsigned)b) << 16); }
__device__ __forceinline__ bf16 f2bf(float f) { unsigned u = __float_as_uint(f); return (bf16)((u + 0x7fffu + ((u >> 16) & 1u)) >> 16); }
__host__ __device__ __forceinline__ int row_modidx(int r) { return r < MC ? 4 : (r - MC) / SEQ; }

namespace pg8 {
#define PG8_LAS __attribute__((address_space(3)))
typedef unsigned short bf16_t;
typedef short bf16x8 __attribute__((ext_vector_type(8)));
typedef float f32x4 __attribute__((ext_vector_type(4)));
typedef unsigned u32x4 __attribute__((ext_vector_type(4)));
constexpr int BM = 256, BK = 64, HALF = 128, HTB = HALF * BK * 2  , STAGE_BYTES = 8 * HTB, NXCD = 8, WGM = 8;

__host__ __device__ __forceinline__ int lds_byte(int r, int c) { const int st = (r >> 4) * 2 + (c >> 5), rr = r & 15, cc = c & 31, ob = rr * 64 + cc * 2; return st * 1024 + (ob ^ (((ob >> 9) & 1) << 5)); }
__host__ __device__ __forceinline__ void stage_rc(int b, int& R, int& C) { const int st = b / 1024, sb = b % 1024, swz = sb ^ (((sb >> 9) & 1) << 5); R = (st >> 1) * 16 + swz / 64; C = (st & 1) * 32 + (swz % 64) / 2; }
__host__ __device__ __forceinline__ int perm32(int rho) { const int n = rho >> 4, i = rho & 15; return 8 * (i >> 2) + 4 * n + (i & 3); }

struct Unit { int pm, pn; };
struct Gemm { const bf16_t* A; const bf16_t* Bt; int M, N, K, pad; };

struct StaticOrder {
    int nM, nN, nwg, G, c;
    __host__ __device__ void init(int M, int N, int G_, int c_) { nM = M / BM; nN = N / BM; nwg = nM * nN; G = G_; c = c_; }
    __host__ __device__ bool next(int i, Unit& u) const {
        const long L = (long)i * G + c; if (L >= nwg) return false;
        int wgid = (int)L; { const int q = nwg / NXCD, r = nwg % NXCD, xcd = wgid % NXCD, off = wgid / NXCD; wgid = (xcd < r ? xcd * (q + 1) : r * (q + 1) + (xcd - r) * q) + off; }
        const int nig = WGM * nN, gid = wgid / nig, fm = gid * WGM, gsz = (nM - fm) < WGM ? (nM - fm) : WGM;
        u.pm = fm + ((wgid % nig) % gsz); u.pn = (wgid % nig) / gsz; return true;
    }
    __device__ __forceinline__ void a_ready(const Unit&) const {}
    __device__ __forceinline__ void done(const Unit&) const {}
};
constexpr int DFF_ = 2816;
__device__ __forceinline__ unsigned cvt_pk_bf16(float lo, float hi) { unsigned r; asm volatile("v_cvt_pk_bf16_f32 %0, %1, %2" : "=v"(r) : "v"(lo), "v"(hi)); return r; }
typedef unsigned u32x2 __attribute__((ext_vector_type(2)));
__device__ __forceinline__ float bflo(unsigned w) { return __uint_as_float(w << 16); }
__device__ __forceinline__ float bfhi(unsigned w) { return __uint_as_float(w & 0xffff0000u); }
__device__ __forceinline__ float sigm(float x) { return __builtin_amdgcn_rcpf(1.f + __expf(-x)); }

struct EpiBf16Plain {
    static constexpr bool PERM = true, AFTER_DRAIN = false;
    bf16_t* O; int ldc, pad;
    __device__ __forceinline__ void operator()(const f32x4 (&acc)[2][2][4][2], const Unit& u, int wr, int wc, int fr, int fq) const {
        const int row0 = u.pm * BM + wr * 64 + fr, col0 = u.pn * BM + wc * 32 + 8 * fq;
#pragma unroll
        for (int ai = 0; ai < 2; ++ai)
#pragma unroll
            for (int m = 0; m < 4; ++m) { bf16_t* rowp = O + (size_t)(row0 + ai * HALF + m * 16) * ldc + col0;
#pragma unroll
                for (int bj = 0; bj < 2; ++bj) { const f32x4 v0 = acc[ai][bj][m][0], v1 = acc[ai][bj][m][1];
                    u32x4 w; w.x = cvt_pk_bf16(v0[0], v0[1]); w.y = cvt_pk_bf16(v0[2], v0[3]); w.z = cvt_pk_bf16(v1[0], v1[1]); w.w = cvt_pk_bf16(v1[2], v1[3]);
                    *(u32x4*)(rowp + bj * HALF) = w; } }
    }
};
struct EpiGlu {
    static constexpr bool PERM = true, AFTER_DRAIN = false;
    bf16_t* Y; const bf16_t* S5Y; const float* bias;
    __device__ __forceinline__ void operator()(const f32x4 (&acc)[2][2][4][2], const Unit& u, int wr, int wc, int fr, int fq) const {
        const int row0 = u.pm * BM + wr * 64 + fr, col0 = u.pn * BM + wc * 32 + 8 * fq;
        f32x4 bv[2][2];
#pragma unroll
        for (int bj = 0; bj < 2; ++bj)
#pragma unroll
            for (int n = 0; n < 2; ++n) bv[bj][n] = *(const f32x4*)(bias + col0 + bj * HALF + 4 * n);
#pragma unroll
        for (int ai = 0; ai < 2; ++ai)
#pragma unroll
            for (int m = 0; m < 4; ++m) { const size_t row = (size_t)(row0 + ai * HALF + m * 16);
#pragma unroll
                for (int bj = 0; bj < 2; ++bj) { const f32x4 v0 = acc[ai][bj][m][0] + bv[bj][0], v1 = acc[ai][bj][m][1] + bv[bj][1];
                    const u32x4 s = *(const u32x4*)(S5Y + row * 512 + col0 + bj * HALF);
                    u32x4 w;
                    w.x = cvt_pk_bf16(bflo(s.x) * sigm(v0[0]), bfhi(s.x) * sigm(v0[1])); w.y = cvt_pk_bf16(bflo(s.y) * sigm(v0[2]), bfhi(s.y) * sigm(v0[3]));
                    w.z = cvt_pk_bf16(bflo(s.z) * sigm(v1[0]), bfhi(s.z) * sigm(v1[1])); w.w = cvt_pk_bf16(bflo(s.w) * sigm(v1[2]), bfhi(s.w) * sigm(v1[3]));
                    *(u32x4*)(Y + row * 1024 + col0 + bj * HALF) = w; } }
    }
};
struct EpiResid {
    static constexpr bool PERM = false, AFTER_DRAIN = false;
    float* XC; float* XO; const float* modl; int off_gate, pad;
    __device__ __forceinline__ void operator()(const f32x4 (&acc)[2][2][4][2], const Unit& u, int wr, int wc, int fr, int fq) const {
        float* xb = u.pm < 4 ? XC + (size_t)u.pm * BM * 1024 : XO + (size_t)(u.pm - 4) * BM * 1024;
        const float* gate = modl + (size_t)(u.pm < 4 ? 4 : (u.pm - 4) >> 4) * 6144 + off_gate;
        const int rl0 = wr * 64 + fr, col0 = u.pn * BM + wc * 32 + 4 * fq;
        f32x4 gv[2][2];
#pragma unroll
        for (int bj = 0; bj < 2; ++bj)
#pragma unroll
            for (int n = 0; n < 2; ++n) gv[bj][n] = *(const f32x4*)(gate + col0 + bj * HALF + n * 16);
#pragma unroll
        for (int ai = 0; ai < 2; ++ai)
#pragma unroll
            for (int m = 0; m < 4; ++m) { float* rowp = xb + (size_t)(rl0 + ai * HALF + m * 16) * 1024 + col0;
#pragma unroll
                for (int bj = 0; bj < 2; ++bj)
#pragma unroll
                    for (int n = 0; n < 2; ++n) { f32x4* p = (f32x4*)(rowp + bj * HALF + n * 16); const f32x4 x = *p; *p = x * 1.681792830507429f + gv[bj][n] * acc[ai][bj][m][n]; }
                asm volatile("" ::: "memory"); }
    }
};
struct EpiUpConv {
    static constexpr bool PERM = true, AFTER_DRAIN = false;
    bf16_t* ACT; const float* cw; const float* cb; const bf16_t* H; const bf16_t* Wt; PG8_LAS float* halo; int pad;
    __device__ __forceinline__ void operator()(const f32x4 (&acc)[2][2][4][2], const Unit& u, int wr, int wc, int fr, int fq) const {
        const int lane = fq * 16 + fr;
        const bool isctx = u.pm < 4;
        PG8_LAS float* hs = halo + (wr * 4 + wc) * 192;
        if (isctx) {
            const int r0 = wr == 0 ? 64 : 63, r1 = wr == 0 ? 127 : 128, r2 = wr == 0 ? 192 : 191;
            const int hi = lane & 15, hrow = hi == 1 ? r1 : (hi == 2 ? r2 : r0);
            const bf16_t* ap = H + (size_t)(u.pm * BM + hrow) * 1024 + 8 * (lane >> 4);
            const bf16_t* bp = Wt + (size_t)(u.pn * BM + wc * 32 + (lane & 15)) * 1024 + 8 * (lane >> 4);
            f32x4 h4[2][2];
#pragma unroll
            for (int bj = 0; bj < 2; ++bj)
#pragma unroll
                for (int nt = 0; nt < 2; ++nt) h4[bj][nt] = (f32x4){0.f, 0.f, 0.f, 0.f};
#pragma unroll 4
            for (int ks = 0; ks < 32; ++ks) {
                const bf16x8 a = *(const bf16x8*)(ap + 32 * ks);
#pragma unroll
                for (int bj = 0; bj < 2; ++bj)
#pragma unroll
                    for (int nt = 0; nt < 2; ++nt) { const bf16x8 b = *(const bf16x8*)(bp + (size_t)(bj * HALF + nt * 16) * 1024 + 32 * ks);
                        h4[bj][nt] = __builtin_amdgcn_mfma_f32_16x16x32_bf16(a, b, h4[bj][nt], 0, 0, 0); }
            }
            if (lane < 16) {
#pragma unroll
                for (int bj = 0; bj < 2; ++bj)
#pragma unroll
                    for (int nt = 0; nt < 2; ++nt) { hs[(bj * 3 + 0) * 32 + nt * 16 + lane] = h4[bj][nt][0]; hs[(bj * 3 + 1) * 32 + nt * 16 + lane] = h4[bj][nt][1]; hs[(bj * 3 + 2) * 32 + nt * 16 + lane] = h4[bj][nt][2]; }
            }
            asm volatile("s_waitcnt lgkmcnt(0)" ::: "memory");
        }
        const int lprev = (lane & 48) | ((lane - 1) & 15), lnext = (lane & 48) | ((lane + 1) & 15);
        const int row0 = u.pm * BM + wr * 64 + fr, ocol = u.pn * HALF + wc * 32 + 8 * fq;
#pragma unroll
        for (int n = 0; n < 2; ++n) {
            f32x4 w0[2], w1[2], w2[2], bb[2];
#pragma unroll
            for (int bj = 0; bj < 2; ++bj) { const int oc = bj * DFF_ + ocol + 4 * n;
                w0[bj] = *(const f32x4*)(cw + oc); w1[bj] = *(const f32x4*)(cw + 2 * DFF_ + oc); w2[bj] = *(const f32x4*)(cw + 4 * DFF_ + oc); bb[bj] = *(const f32x4*)(cb + oc); }
#pragma unroll
            for (int ai = 0; ai < 2; ++ai) {
                const int ip = wr == 0 ? (ai == 0 ? -1 : 1) : (ai == 0 ? 0 : 2);
                const int in = wr == 0 ? (ai == 0 ? 0 : 2) : (ai == 0 ? 1 : -1);
                f32x4 hp[2], hn[2];
#pragma unroll
                for (int bj = 0; bj < 2; ++bj) { hp[bj] = (f32x4){0.f, 0.f, 0.f, 0.f}; hn[bj] = (f32x4){0.f, 0.f, 0.f, 0.f};
                    if (isctx) { if (ip >= 0) hp[bj] = *(const PG8_LAS f32x4*)(hs + (bj * 3 + ip) * 32 + 8 * fq + 4 * n); if (in >= 0) hn[bj] = *(const PG8_LAS f32x4*)(hs + (bj * 3 + in) * 32 + 8 * fq + 4 * n); } }
#pragma unroll
                for (int m = 0; m < 4; ++m) {
                    f32x4 o[2];
#pragma unroll
                    for (int bj = 0; bj < 2; ++bj) {
                        const f32x4 cur = acc[ai][bj][m][n];
                        const f32x4 offp = (fr == 15 && m > 0) ? acc[ai][bj][m > 0 ? m - 1 : 0][n] : cur;
                        const f32x4 offn = (fr == 0 && m < 3) ? acc[ai][bj][m < 3 ? m + 1 : 3][n] : cur;
                        f32x4 pv, nv;
#pragma unroll
                        for (int e = 0; e < 4; ++e) { pv[e] = __shfl(offp[e], lprev, 64); nv[e] = __shfl(offn[e], lnext, 64); }
                        if (m == 0) pv = fr == 0 ? hp[bj] : pv;
                        if (m == 3) nv = fr == 15 ? hn[bj] : nv;
                        o[bj] = bb[bj] + w0[bj] * pv + w1[bj] * cur + w2[bj] * nv;
                    }
                    float a0 = o[0][0], a1 = o[0][1], a2 = o[0][2], a3 = o[0][3];
                    u32x2 w; w.x = cvt_pk_bf16(a0 * sigm(a0) * o[1][0], a1 * sigm(a1) * o[1][1]); w.y = cvt_pk_bf16(a2 * sigm(a2) * o[1][2], a3 * sigm(a3) * o[1][3]);
                    *(u32x2*)(ACT + (size_t)(row0 + ai * HALF + m * 16) * DFF_ + ocol + 4 * n) = w;
                }
            }
        }
    }
};

template <class Epi, class Sched, bool ALIGN_EPI = false, bool SP2 = false>
__device__ __forceinline__ void gemm_phase(PG8_LAS unsigned char* lds, const Gemm g, const Sched& S, const Epi& E) {
    int tid_ = threadIdx.x; asm volatile("" : "+v"(tid_));
    const int tid = tid_, wid = __builtin_amdgcn_readfirstlane(tid >> 6), lane = tid & 63, wr = wid >> 2, wc = wid & 3, fr = lane & 15, fq = lane >> 4;
    const int K = g.K, nt = K / BK;
    unsigned voffA[2], voffB[2];
#pragma unroll
    for (int i = 0; i < 2; ++i) { int R, C; stage_rc(tid * 16 + i * 8192, R, C); const int Rb = Epi::PERM ? ((R & ~31) + perm32(R & 31)) : R;
        voffA[i] = (unsigned)(R * K + C) * 2u; voffB[i] = (unsigned)(Rb * K + C) * 2u; }
    const size_t kstep = (size_t)(BK * 2);
    const size_t hstep = (size_t)HALF * K * 2;
    const size_t tstep = 2 * hstep;
    const unsigned ldsw = (unsigned)wid * 1024u;
    const int aoff = lds_byte(wr * 64 + fr, fq * 8), boff = lds_byte(wc * 32 + fr, fq * 8);
#define PG8_SA(b, h) (((b) * 2 + (h)) * HTB)
#define PG8_SB(b, h) ((4 + (b) * 2 + (h)) * HTB)
#define PG8_STAGE(bufoff, gbase, voff) do { _Pragma("unroll") for (int _i = 0; _i < 2; ++_i) \
        __builtin_amdgcn_global_load_lds((const unsigned*)((const char*)(gbase) + (voff)[_i]), (PG8_LAS unsigned*)(lds + (bufoff) + ldsw + _i * 8192), 16, 0, 0); } while (0)
#define PG8_LDA(dst, b, h) do { _Pragma("unroll") for (int m = 0; m < 4; ++m) _Pragma("unroll") for (int k = 0; k < 2; ++k) dst[m][k] = *(const PG8_LAS bf16x8*)(lds + PG8_SA(b, h) + aoff + m * 2048 + k * 1024); } while (0)
#define PG8_LDB(dst, b, h) do { _Pragma("unroll") for (int n = 0; n < 2; ++n) _Pragma("unroll") for (int k = 0; k < 2; ++k) dst[n][k] = *(const PG8_LAS bf16x8*)(lds + PG8_SB(b, h) + boff + n * 2048 + k * 1024); } while (0)
#define PG8_MMA(ai, bj, At, Bt) do { __builtin_amdgcn_s_setprio(1); _Pragma("unroll") for (int m = 0; m < 4; ++m) _Pragma("unroll") for (int n = 0; n < 2; ++n) _Pragma("unroll") for (int k = 0; k < 2; ++k) \
        acc[ai][bj][m][n] = __builtin_amdgcn_mfma_f32_16x16x32_bf16(Bt[n][k], At[m][k], acc[ai][bj][m][n], 0, 0, 0); __builtin_amdgcn_s_setprio(0); } while (0)
#define PG8_WAIT_V(n) asm volatile("s_waitcnt vmcnt(" #n ")" ::: "memory")
#define PG8_WAIT_L(n) asm volatile("s_waitcnt lgkmcnt(" #n ")" ::: "memory")
#define PG8_BAR __builtin_amdgcn_s_barrier()
#define PG8_SCHED __builtin_amdgcn_sched_barrier(0)
    Unit cur, nxt; int ui = 0;
    if (!S.next(0, cur)) return;
    f32x4 acc[2][2][4][2];
#pragma unroll
    for (int a = 0; a < 2; ++a)
#pragma unroll
        for (int b = 0; b < 2; ++b)
#pragma unroll
            for (int m = 0; m < 4; ++m)
#pragma unroll
                for (int n = 0; n < 2; ++n) acc[a][b][m][n] = (f32x4){0.f, 0.f, 0.f, 0.f};
    bf16x8 At[4][2], B0[2][2], B1[2][2];
    const char* cA = (const char*)g.A + (size_t)cur.pm * tstep; const char* cB = (const char*)g.Bt + (size_t)cur.pn * tstep;
    S.a_ready(cur);
    if constexpr (SP2) {
        PG8_STAGE(PG8_SB(0, 0), cB, voffB); PG8_STAGE(PG8_SB(0, 1), cB + hstep, voffB); PG8_STAGE(PG8_SA(0, 0), cA, voffA); PG8_STAGE(PG8_SA(0, 1), cA + hstep, voffA);
        if (wr == 1) PG8_BAR;
        PG8_WAIT_V(2); PG8_BAR;
        PG8_STAGE(PG8_SB(1, 0), cB + kstep, voffB); PG8_STAGE(PG8_SA(1, 0), cA + kstep, voffA); PG8_STAGE(PG8_SB(1, 1), cB + hstep + kstep, voffB);
        PG8_WAIT_V(6); PG8_BAR;
    } else {
        PG8_STAGE(PG8_SB(0, 0), cB, voffB); PG8_STAGE(PG8_SA(0, 0), cA, voffA); PG8_STAGE(PG8_SB(0, 1), cB + hstep, voffB); PG8_STAGE(PG8_SA(0, 1), cA + hstep, voffA);
        if (wr == 1) PG8_BAR;
        PG8_WAIT_V(4); PG8_BAR;
        PG8_STAGE(PG8_SB(1, 0), cB + kstep, voffB); PG8_STAGE(PG8_SA(1, 0), cA + kstep, voffA); PG8_STAGE(PG8_SB(1, 1), cB + hstep + kstep, voffB);
        PG8_WAIT_V(6); PG8_BAR;
    }
    for (;;) {
        const bool has_next = S.next(ui + 1, nxt);
        const char* nA = has_next ? (const char*)g.A + (size_t)nxt.pm * tstep : cA; const char* nB = has_next ? (const char*)g.Bt + (size_t)nxt.pn * tstep : cB;
        for (int t = 0; t < nt; t += 2) {
            const bool last = (t == nt - 2);
            const char* a1 = cA + (size_t)(t + 1) * kstep;
            const char* a2 = last ? nA : cA + (size_t)(t + 2) * kstep; const char* b2 = last ? nB : cB + (size_t)(t + 2) * kstep;
            const char* a3 = a2 + kstep; const char* b3 = b2 + kstep;
            if (last && has_next) S.a_ready(nxt);
            if constexpr (SP2) {
            PG8_LDB(B0, 0, 0); PG8_LDB(B1, 0, 1); PG8_SCHED; PG8_LDA(At, 0, 0); PG8_STAGE(PG8_SA(1, 1), a1 + hstep, voffA);
            PG8_WAIT_V(8); PG8_WAIT_L(0); PG8_BAR; PG8_MMA(0, 0, At, B0); PG8_MMA(0, 1, At, B1); PG8_BAR; PG8_SCHED;
            PG8_LDA(At, 0, 1); PG8_STAGE(PG8_SB(0, 0), b2, voffB); PG8_STAGE(PG8_SB(0, 1), b2 + hstep, voffB); PG8_STAGE(PG8_SA(0, 0), a2, voffA);
            PG8_WAIT_V(8); PG8_WAIT_L(0); PG8_BAR; PG8_MMA(1, 0, At, B0); PG8_MMA(1, 1, At, B1); PG8_BAR; PG8_SCHED;
            PG8_LDB(B0, 1, 0); PG8_LDB(B1, 1, 1); PG8_SCHED; PG8_LDA(At, 1, 0); PG8_STAGE(PG8_SA(0, 1), a2 + hstep, voffA);
            PG8_WAIT_V(8); PG8_WAIT_L(0); PG8_BAR; PG8_MMA(0, 0, At, B0); PG8_MMA(0, 1, At, B1); PG8_BAR; PG8_SCHED;
            PG8_LDA(At, 1, 1); PG8_STAGE(PG8_SB(1, 0), b3, voffB); PG8_STAGE(PG8_SB(1, 1), b3 + hstep, voffB); PG8_STAGE(PG8_SA(1, 0), a3, voffA);
            PG8_WAIT_V(8); PG8_WAIT_L(0); PG8_BAR; PG8_MMA(1, 0, At, B0); PG8_MMA(1, 1, At, B1); PG8_BAR; PG8_SCHED;
            } else {
            PG8_LDB(B0, 0, 0); PG8_SCHED; PG8_LDA(At, 0, 0); PG8_STAGE(PG8_SA(1, 1), a1 + hstep, voffA);
            PG8_WAIT_L(8); PG8_BAR; PG8_WAIT_L(0); PG8_MMA(0, 0, At, B0); PG8_BAR; PG8_SCHED;
            PG8_LDB(B1, 0, 1); PG8_STAGE(PG8_SB(0, 0), b2, voffB);
            PG8_BAR; PG8_WAIT_L(0); PG8_MMA(0, 1, At, B1); PG8_BAR;
            PG8_LDA(At, 0, 1); PG8_STAGE(PG8_SA(0, 0), a2, voffA);
            PG8_BAR; PG8_WAIT_L(0); PG8_MMA(1, 0, At, B0); PG8_BAR; PG8_SCHED;
            PG8_STAGE(PG8_SB(0, 1), b2 + hstep, voffB);
            PG8_WAIT_V(6); PG8_BAR; PG8_MMA(1, 1, At, B1); PG8_BAR;
            PG8_LDB(B0, 1, 0); PG8_SCHED; PG8_LDA(At, 1, 0); PG8_STAGE(PG8_SA(0, 1), a2 + hstep, voffA);
            PG8_WAIT_L(8); PG8_BAR; PG8_WAIT_L(0); PG8_MMA(0, 0, At, B0); PG8_BAR; PG8_SCHED;
            PG8_LDB(B1, 1, 1); PG8_STAGE(PG8_SB(1, 0), b3, voffB);
            PG8_BAR; PG8_WAIT_L(0); PG8_MMA(0, 1, At, B1); PG8_BAR;
            PG8_LDA(At, 1, 1); PG8_STAGE(PG8_SA(1, 0), a3, voffA);
            PG8_BAR; PG8_WAIT_L(0); PG8_MMA(1, 0, At, B0); PG8_BAR; PG8_SCHED;
            PG8_STAGE(PG8_SB(1, 1), b3 + hstep, voffB);
            PG8_WAIT_V(6); PG8_BAR; PG8_MMA(1, 1, At, B1); PG8_BAR;
            }
        }
        if constexpr (ALIGN_EPI) { if (wr == 0) PG8_BAR; }
        if constexpr (!Epi::AFTER_DRAIN) { E(acc, cur, wr, wc, fr, fq); S.done(cur); }
        if (!has_next) break;
#pragma unroll
        for (int a = 0; a < 2; ++a)
#pragma unroll
            for (int b = 0; b < 2; ++b)
#pragma unroll
                for (int m = 0; m < 4; ++m)
#pragma unroll
                    for (int n = 0; n < 2; ++n) acc[a][b][m][n] = (f32x4){0.f, 0.f, 0.f, 0.f};
        cur = nxt; cA = nA; cB = nB; ++ui;
        if constexpr (ALIGN_EPI) { if (wr == 1) PG8_BAR; }
    }
    PG8_WAIT_V(0);
    if constexpr (!ALIGN_EPI) { if (wr == 0) PG8_BAR; }
    PG8_BAR;
    if constexpr (Epi::AFTER_DRAIN) { E.fused(acc, cur, wr, wc, fr, fq, lds, wid, lane); S.done(cur); }
#undef PG8_SA
#undef PG8_SB
#undef PG8_STAGE
#undef PG8_LDA
#undef PG8_LDB
#undef PG8_MMA
#undef PG8_WAIT_V
#undef PG8_WAIT_L
#undef PG8_BAR
#undef PG8_SCHED
}
}

#define GAS __attribute__((address_space(1)))
#define LAS __attribute__((address_space(3)))
typedef float f32x4 __attribute__((ext_vector_type(4)));
typedef unsigned u32x2 __attribute__((ext_vector_type(2)));
typedef unsigned u32x4 __attribute__((ext_vector_type(4)));
constexpr int NT = 512;
constexpr int LDS_BYTES = 147456;
constexpr int RING_BYTES = 131072, LDSCTL_OFF = RING_BYTES, MISC_OFF = LDSCTL_OFF + 320, HALO_OFF = 132096;
static_assert(HALO_OFF + 8 * 768 <= LDS_BYTES && MISC_OFF + 128 <= HALO_OFF, "LDS map");
#define XB_TMO      128
#define XB_XCNT(j)  (256  + 64 * (j))
#define XB_XSUB(j)  (1280 + 64 * (j))
#define XB_XGEN(j)  (2304 + 64 * (j))
#define XB_TOP      3328
#define XB_TOPGEN   3392
#define XCD_BAR_WORDS 3456
#define XB_SPIN_CAP (1u << 18)

__device__ __forceinline__ unsigned xb_ld(unsigned* p)              { return __hip_atomic_load(p, __ATOMIC_RELAXED, __HIP_MEMORY_SCOPE_AGENT); }
__device__ __forceinline__ unsigned xb_add(unsigned* p, unsigned v) { return __hip_atomic_fetch_add(p, v, __ATOMIC_RELAXED, __HIP_MEMORY_SCOPE_AGENT); }
__device__ __forceinline__ unsigned xb_xcc_id() { return (unsigned)__builtin_amdgcn_s_getreg((3 << 11) | 20) & 0xFu; }
#define XB_SPIN(cond, bar) do { unsigned _sp = 0; while (cond) { __builtin_amdgcn_s_sleep(1); \
    if ((++_sp & 255u) == 0u) { if (xb_ld(&(bar)[XB_TMO])) break; if (_sp > XB_SPIN_CAP) { atomicAdd(&(bar)[XB_TMO], 1u); break; } } } } while (0)

struct XcdBarrier {
    unsigned* bar; unsigned x;
    volatile LAS unsigned* st;
};

__device__ __forceinline__ XcdBarrier xcd_barrier_post(unsigned* bar, volatile LAS unsigned* st) {
    XcdBarrier b; b.bar = bar; b.x = xb_xcc_id(); b.st = st;
    if (threadIdx.x == 0) (void)xb_add(&bar[XB_XCNT(b.x)], 1u);
    return b;
}
__device__ __forceinline__ void xcd_barrier_complete(unsigned* bar, unsigned x, unsigned& nloc, unsigned& nx) {
    const unsigned G = gridDim.x * gridDim.y * gridDim.z;
    unsigned sum, cnt, mine, sp = 0u;
    for (;;) {
        sum = 0u; cnt = 0u; mine = 0u;
#pragma unroll
        for (unsigned j = 0; j < 16; ++j) { const unsigned c = xb_ld(&bar[XB_XCNT(j)]); sum += c; cnt += (c > 0u) ? 1u : 0u; mine = (j == x) ? c : mine; }
        if (sum == G) break;
        __builtin_amdgcn_s_sleep(1);
        if ((++sp & 255u) == 0u) { if (xb_ld(&bar[XB_TMO])) break; if (sp > XB_SPIN_CAP) { atomicAdd(&bar[XB_TMO], 1u); break; } }
    }
    nloc = mine > 0u ? mine : 1u; nx = cnt > 0u ? cnt : 1u;
}

__device__ __forceinline__ void xcd_barrier(const XcdBarrier& b) {
    asm volatile("s_waitcnt vmcnt(0)" ::: "memory");
    __syncthreads();
    if (threadIdx.x == 0) {
        unsigned* bar = b.bar; const unsigned bx_ = (unsigned)__builtin_amdgcn_readfirstlane((int)xb_xcc_id());
        __builtin_amdgcn_s_waitcnt(0);
        unsigned nloc = b.st[0], nx = b.st[1];
        if (nloc == 0u) { xcd_barrier_complete(bar, bx_, nloc, nx); b.st[0] = nloc; b.st[1] = nx; }
        const unsigned old = xb_add(&bar[XB_XSUB(bx_)], 1u);
        const unsigned gen = old / nloc;
        if (old + 1u == (gen + 1u) * nloc) {
            __builtin_amdgcn_fence(__ATOMIC_RELEASE, "agent");
            asm volatile("s_waitcnt vmcnt(0)" ::: "memory");
            const unsigned og = xb_add(&bar[XB_TOP], 1u);
            const unsigned tg = og / nx;
            if (og + 1u == (tg + 1u) * nx) xb_add(&bar[XB_TOPGEN], 1u);
            else XB_SPIN(xb_ld(&bar[XB_TOPGEN]) == tg, bar);
            __builtin_amdgcn_fence(__ATOMIC_ACQUIRE, "agent");
            xb_add(&bar[XB_XGEN(bx_)], 1u);
            asm volatile("s_waitcnt vmcnt(0)" ::: "memory");
        } else {
            XB_SPIN(xb_ld(&bar[XB_XGEN(bx_)]) == gen, bar);
            __builtin_amdgcn_fence(__ATOMIC_ACQUIRE, "agent");
            asm volatile("s_waitcnt vmcnt(0)" ::: "memory");
        }
    }
    __syncthreads();
}

constexpr size_t MiB = 1u << 20;
constexpr size_t WS_CTL = 0, CTL_ZERO_BYTES = 64 * 1024, WS_MISC = 1 * MiB, WS_XC = 5 * MiB, WS_WIN = 9 * MiB, WS_WGLU = 33 * MiB, WS_WOUT = 35 * MiB, WS_WUP = 43 * MiB, WS_WDN = 87 * MiB,
                 WS_H = 109 * MiB, WS_P = 143 * MiB, WS_OFB = 245 * MiB, WS_S5Y = 279 * MiB, WS_Y = 296 * MiB, WS_S5M = 330 * MiB, WS_END = 378 * MiB;
constexpr size_t WS_ACT = WS_P;
static_assert((size_t)M * INC * 2 <= 102 * MiB && (size_t)M * D * 2 <= 34 * MiB && (size_t)M * DFF * 2 <= 102 * MiB, "ws map");
constexpr int CW_BAR = 1024;
static_assert((CW_BAR + XCD_BAR_WORDS) * 4 <= (int)CTL_ZERO_BYTES, "ctl");

struct Args { const float* in[N_IN]; float* out; unsigned char* ws; int pad0, pad1; };
struct Bufs {
    float *MOD, *LB, *AB, *BB, *XC; float* A16; bf16 *WIN, *WGLU, *WOUT, *WUP, *WDN, *H, *P, *ACT, *OF, *OB, *S5Y, *Y, *S5M;
};
__device__ __forceinline__ float* xrow_ptr(float* xc, float* xo, int r) { return r < MC ? xc + (size_t)r * D : xo + (size_t)(r - MC) * D; }
__device__ __forceinline__ float wave_sum(float v) {
#pragma unroll
    for (int o = 1; o < 64; o <<= 1) v += __shfl_xor(v, o);
    return v;
}
__device__ __forceinline__ unsigned pk2(float lo, float hi) { return (unsigned)f2bf(lo) | ((unsigned)f2bf(hi) << 16); }

#define TIDX tid_fresh()
__device__ __forceinline__ int tid_fresh() { int t = threadIdx.x; asm volatile("" : "+v"(t)); return t; }
__device__ __forceinline__ void p_mod(const Args& a, const Bufs& B, LAS unsigned char* lds, int vcu, int G) {
    LAS float* sc = (LAS float*)lds;
    LAS float* part = sc + 5 * 1024;
    const int tid = TIDX;
    for (int i = tid; i < 5 * 1024; i += NT) { const int r = i >> 10, k = i & 1023; const float c = r < 4 ? a.in[I_C][r * D + k] : a.in[I_CCTX][k]; sc[i] = siluf_(c); }
    __syncthreads();
    const int kq = tid >> 7, jc = tid & 127;
    for (int it = vcu; it < DEPTH * 48; it += G) {
        const int l = it / 48, j0 = (it % 48) * 128;
        const float* w = a.in[I_WMOD] + (size_t)l * D * 6 * D + (size_t)(kq * 256) * 6 * D + j0 + jc;
        float acc[5] = {0.f, 0.f, 0.f, 0.f, 0.f};
#pragma unroll 8
        for (int k = 0; k < 256; ++k) { const float wv = w[(size_t)k * 6 * D];
#pragma unroll
            for (int r = 0; r < 5; ++r) acc[r] += sc[r * 1024 + kq * 256 + k] * wv; }
#pragma unroll
        for (int r = 0; r < 5; ++r) part[(kq * 5 + r) * 128 + jc] = acc[r];
        __syncthreads();
        if (kq == 0) {
#pragma unroll
            for (int r = 0; r < 5; ++r) B.MOD[((size_t)l * 5 + r) * 6 * D + j0 + jc] = a.in[I_BMOD][l * 6 * D + j0 + jc] + part[r * 128 + jc] + part[(5 + r) * 128 + jc] + part[(10 + r) * 128 + jc] + part[(15 + r) * 128 + jc];
        }
        __syncthreads();
    }
}
__device__ __forceinline__ void p_small(const Args& a, const Bufs& B, int vcu, int G) {
    const int gt = vcu * NT + TIDX, NGT = G * NT;
    for (int idx = gt; idx < 2 * HGW; idx += NGT) {
        float v[DEPTH], mx = -1e30f;
#pragma unroll
        for (int l = 0; l < DEPTH; ++l) { v[l] = a.in[I_HGLB][l * 2 * HGW + idx]; mx = fmaxf(mx, v[l]); }
        float s = 0.f;
#pragma unroll
        for (int l = 0; l < DEPTH; ++l) { v[l] = __expf(v[l] - mx); s += v[l]; }
        float cum = 0.f, first = 0.f;
#pragma unroll
        for (int l = 0; l < DEPTH; ++l) { cum += v[l] / s; if (l == 0) first = cum; B.LB[l * 2 * HGW + idx] = cum - first; }
    }
    for (int idx = gt; idx < DEPTH * 2 * S5G * S5P; idx += NGT) {
        const int ldg = idx / S5P;
        const float lr = a.in[I_LRE][idx], li = a.in[I_LIM][idx], dt = expf(a.in[I_LDT][ldg]);
        const float mag = expf(lr * dt), ang = li * dt;
        const float ar = mag * cosf(ang), ai = mag * sinf(ang);
        B.AB[idx * 2] = ar; B.AB[idx * 2 + 1] = ai;
        const float den = lr * lr + li * li, nr = ar - 1.f, ni = ai;
        const float cr = (nr * lr + ni * li) / den, ci = (ni * lr - nr * li) / den;
        for (int h = 0; h < S5H; ++h) {
            const float br = a.in[I_BRE][(size_t)idx * S5H + h], bi = a.in[I_BIM][(size_t)idx * S5H + h];
            B.BB[((size_t)idx * S5H + h) * 2] = cr * br - ci * bi; B.BB[((size_t)idx * S5H + h) * 2 + 1] = cr * bi + ci * br;
        }
    }
    { const f32x4* s = (const f32x4*)a.in[I_X]; f32x4* d = (f32x4*)a.out; for (size_t i = gt; i < (size_t)MX * D / 4; i += NGT) d[i] = s[i]; }
    { const f32x4* s = (const f32x4*)a.in[I_CTX]; f32x4* d = (f32x4*)B.XC; for (size_t i = gt; i < (size_t)MC * D / 4; i += NGT) d[i] = s[i]; }
}
__device__ __forceinline__ void wprep_tile(const float* W, bf16* Wt, int K, int N, int mode, int tn, int tk, LAS float* tile, int t256) {
    const int n0 = tn * 64, k0 = tk * 64, tx = t256 & 63, ty = t256 >> 6;
    const int np = n0 + tx; const int nsrc = mode == 1 ? (((np & 255) < 128 ? 0 : DFF) + 128 * (np >> 8) + (np & 127)) : np;
    for (int i = ty; i < 64; i += 4) tile[i * 65 + tx] = W[(size_t)(k0 + i) * N + nsrc];
    __syncthreads();
    for (int i = ty; i < 64; i += 4) Wt[(size_t)(n0 + i) * K + k0 + tx] = f2bf(tile[tx * 65 + i]);
    __syncthreads();
}
__device__ __forceinline__ void p_wprep(const Args& a, const Bufs& B, LAS unsigned char* lds, int vcu, int G) {
    constexpr int T_IN = 768, T_GLU = 64, T_OUT = 256, T_UP = 1408, T_DN = 704, T_L = T_IN + T_GLU + T_OUT + T_UP + T_DN;
    const int half = TIDX >> 8, t256 = TIDX & 255;
    LAS float* tile = (LAS float*)lds + half * (64 * 65);
    for (int it = vcu; it < DEPTH * T_L / 2; it += G) {
        const int item = it * 2 + half; const int l = item / T_L; int r = item % T_L;
        if (r < T_IN) { wprep_tile(a.in[I_WIN] + (size_t)l * D * INC, B.WIN + (size_t)l * INC * D, D, INC, 0, r % 48, r / 48, tile, t256); continue; } r -= T_IN;
        if (r < T_GLU) { wprep_tile(a.in[I_WGLU] + (size_t)l * S5W * S5W, B.WGLU + (size_t)l * S5W * S5W, S5W, S5W, 0, r % 8, r / 8, tile, t256); continue; } r -= T_GLU;
        if (r < T_OUT) { wprep_tile(a.in[I_WOUT] + (size_t)l * D * D, B.WOUT + (size_t)l * D * D, D, D, 0, r % 16, r / 16, tile, t256); continue; } r -= T_OUT;
        if (r < T_UP) { wprep_tile(a.in[I_WUP] + (size_t)l * D * 2 * DFF, B.WUP + (size_t)l * 2 * DFF * D, D, 2 * DFF, 1, r % 88, r / 88, tile, t256); continue; } r -= T_UP;
        wprep_tile(a.in[I_WDOWN] + (size_t)l * DFF * D, B.WDN + (size_t)l * D * DFF, DFF, D, 0, r % 16, r / 16, tile, t256);
    }
}
__device__ __forceinline__ void p_modulate(const Args& a, const Bufs& B, const float* modl, int off_sh, int off_sc, int vcu, int G) {
    const int lane = TIDX & 63, gw = vcu * 8 + (TIDX >> 6), NGW = G * 8;
    for (int r = gw; r < M; r += NGW) {
        const f32x4* x = (const f32x4*)xrow_ptr(B.XC, a.out, r) + lane; const float* mr = modl + (size_t)row_modidx(r) * 6 * D;
        u32x2* o = (u32x2*)(B.H + (size_t)r * D) + lane;
#pragma unroll
        for (int j = 0; j < 4; ++j) { const f32x4 v = x[64 * j], sc = *((const f32x4*)(mr + off_sc) + lane + 64 * j), sh = *((const f32x4*)(mr + off_sh) + lane + 64 * j);
            u32x2 w; w.x = pk2(v[0] * (1.f + sc[0]) + sh[0], v[1] * (1.f + sc[1]) + sh[1]); w.y = pk2(v[2] * (1.f + sc[2]) + sh[2], v[3] * (1.f + sc[3]) + sh[3]); o[64 * j] = w; }
    }
}
__device__ __forceinline__ void p_ln(const Args& a, const Bufs& B, const float* lg, const float* lbv, const float* modn, int off_sh, int off_sc, int vcu, int G) {
    const int lane = TIDX & 63, gw = vcu * 8 + (TIDX >> 6), NGW = G * 8;
    for (int r = gw; r < M; r += NGW) {
        f32x4* x = (f32x4*)xrow_ptr(B.XC, a.out, r) + lane;
        f32x4 v[4]; float s = 0.f;
#pragma unroll
        for (int j = 0; j < 4; ++j) { v[j] = x[64 * j]; s += (v[j][0] + v[j][1]) + (v[j][2] + v[j][3]); }
        const float mean = wave_sum(s) * (1.f / D); float q = 0.f;
#pragma unroll
        for (int j = 0; j < 4; ++j) { v[j] = v[j] - mean; q += (v[j][0] * v[j][0] + v[j][1] * v[j][1]) + (v[j][2] * v[j][2] + v[j][3] * v[j][3]); }
        const float rstd = rsqrtf(wave_sum(q) * (1.f / D) + LN_EPS);
        const float* mr = modn ? modn + (size_t)row_modidx(r) * 6 * D : nullptr;
        u32x2* o = (u32x2*)(B.H + (size_t)r * D) + lane;
#pragma unroll
        for (int j = 0; j < 4; ++j) { const f32x4 g = *((const f32x4*)lg + lane + 64 * j), bb = *((const f32x4*)lbv + lane + 64 * j); const f32x4 y = v[j] * rstd * g + bb; x[64 * j] = y;
            if (mr) { const f32x4 sc = *((const f32x4*)(mr + off_sc) + lane + 64 * j), sh = *((const f32x4*)(mr + off_sh) + lane + 64 * j);
                u32x2 w; w.x = pk2(y[0] * (1.f + sc[0]) + sh[0], y[1] * (1.f + sc[1]) + sh[1]); w.y = pk2(y[2] * (1.f + sc[2]) + sh[2], y[3] * (1.f + sc[3]) + sh[3]); o[64 * j] = w; } }
    }
}

__device__ __forceinline__ int s5_row(int b, int d, int s) {
    if (s < CTX) { const int t = d ? CTX - 1 - s : s; return b * CTX + t; }
    const int t = d ? SEQ - 1 - (s - CTX) : (s - CTX); return MC + b * SEQ + t;
}
__device__ __forceinline__ void p_mixout(const Args& a, const Bufs& B, int l, LAS unsigned char* lds, int vcu, int G) {
    LAS float* red = (LAS float*)lds;
    const float* nw = a.in[I_HGNW] + (size_t)l * HD;
    const int c = TIDX;
    for (int r = vcu; r < M; r += G) {
        const bf16* pr = B.P + (size_t)r * INC;
        const float o = bf2f(B.OF[(size_t)r * HGW + c]) + bf2f(B.OB[(size_t)r * HGW + c]);
        float s = o * o;
        for (int off = 32; off >= 1; off >>= 1) s += __shfl_xor(s, off);
        if ((c & 63) == 0) red[c >> 6] = s;
        __syncthreads();
        const float ms = (red[(c >> 7) * 2] + red[(c >> 7) * 2 + 1]) * (1.f / 128.f);
        const float g = bf2f(pr[2560 + c]);
        B.Y[(size_t)r * D + 512 + c] = f2bf(o * rsqrtf(ms + RMS_EPS) * nw[c & 127] * siluf_(g));
        __syncthreads();
    }
}

constexpr size_t S5M_W1 = 256 * 256, S5M_W3 = 256 * 512, S5M_PER = S5M_W1 + S5M_W3;
__device__ __forceinline__ void p_s5mats(const Args& a, bf16* S5M, float* A16, LAS unsigned char* lds, int vcu, int G) {
    LAS float* pw = (LAS float*)lds;
    LAS float* bb = pw + 2 * 17 * 64 * 2;
    LAS float* cc = bb + 2 * 64 * 16 * 2;
    LAS float* Kn = cc + 2 * 16 * 64 * 2;
    const int tid = TIDX;
    for (int it = vcu; it < DEPTH * S5G; it += G) {
        const int l = it / S5G, g = it % S5G;
        for (int i = tid; i < 2 * 17 * 64; i += NT) { const int p = i & 63, n = (i >> 6) % 17, d = i / (17 * 64);
            const int li_ = ((l * 2 + d) * S5G + g) * S5P + p; const float lr = a.in[I_LRE][li_], li = a.in[I_LIM][li_], dt = expf(a.in[I_LDT][(l * 2 + d) * S5G + g]);
            const float mag = expf((float)n * lr * dt), ang = (float)n * li * dt; pw[i * 2] = mag * cosf(ang); pw[i * 2 + 1] = mag * sinf(ang); }
        for (int i = tid; i < 2 * 64 * 16; i += NT) { const int h = i & 15, p = (i >> 4) & 63, d = i >> 10;
            const int li_ = ((l * 2 + d) * S5G + g) * S5P + p; const float lr = a.in[I_LRE][li_], li = a.in[I_LIM][li_], dt = expf(a.in[I_LDT][(l * 2 + d) * S5G + g]);
            const float mag = expf(lr * dt), ang = li * dt; const float ar = mag * cosf(ang), ai = mag * sinf(ang);
            const float den = lr * lr + li * li, nr = ar - 1.f, ni = ai; const float cr = (nr * lr + ni * li) / den, ci = (ni * lr - nr * li) / den;
            const float br = a.in[I_BRE][(size_t)li_ * S5H + h], bi = a.in[I_BIM][(size_t)li_ * S5H + h];
            bb[i * 2] = cr * br - ci * bi; bb[i * 2 + 1] = cr * bi + ci * br; }
        for (int i = tid; i < 2 * 16 * 64; i += NT) { const int p = i & 63, h = (i >> 6) & 15, d = i >> 10; const size_t ci_ = ((size_t)((l * 2 + d) * S5G + g) * S5H + h) * S5P + p;
            cc[i * 2] = a.in[I_CRE][ci_]; cc[i * 2 + 1] = a.in[I_CIM][ci_]; }
        __syncthreads();
        for (int i = tid; i < 2 * 16 * 16 * 16; i += NT) { const int h = i & 15, hp = (i >> 4) & 15, n = (i >> 8) & 15, d = i >> 12; float s = 0.f;
            for (int p = 0; p < 64; ++p) { const float cr = cc[((d * 16 + hp) * 64 + p) * 2], ci = cc[((d * 16 + hp) * 64 + p) * 2 + 1], ar = pw[((d * 17 + n) * 64 + p) * 2], ai = pw[((d * 17 + n) * 64 + p) * 2 + 1];
                const float tr = cr * ar - ci * ai, ti = cr * ai + ci * ar; s += tr * bb[((d * 64 + p) * 16 + h) * 2] - ti * bb[((d * 64 + p) * 16 + h) * 2 + 1]; }
            Kn[i] = s; }
        __syncthreads();
        bf16* W1 = S5M + (size_t)it * S5M_PER; bf16* W3 = W1 + S5M_W1;
        for (int c = tid; c < 256 * 32; c += NT) {
            const int n = c >> 5, k0 = (c & 31) * 8, d = n >> 7, ri = (n >> 6) & 1, p = n & 63, i = k0 >> 4, h0 = k0 & 15, e = d == 0 ? 15 - i : i;
            const float ar = pw[((d * 17 + e) * 64 + p) * 2], ai = pw[((d * 17 + e) * 64 + p) * 2 + 1]; unsigned w[4];
#pragma unroll
            for (int q = 0; q < 4; ++q) { float v[2];
#pragma unroll
                for (int t = 0; t < 2; ++t) { const int h = h0 + 2 * q + t; const float br = bb[((d * 64 + p) * 16 + h) * 2], bi = bb[((d * 64 + p) * 16 + h) * 2 + 1]; v[t] = ri == 0 ? ar * br - ai * bi : ar * bi + ai * br; }
                w[q] = pk2(v[0], v[1]); }
            *(u32x4*)(W1 + (size_t)n * 256 + k0) = (u32x4){w[0], w[1], w[2], w[3]};
        }
        const float* dsk = a.in[I_SD] + (size_t)l * S5W + g * 16;
        for (int c = tid; c < 256 * 64; c += NT) {
            const int n = c >> 6, k0 = (c & 63) * 8, j = n >> 4, hp = n & 15; float v[8];
            if (k0 < 256) { const int i = k0 >> 4, h0 = k0 & 15;
#pragma unroll
                for (int t = 0; t < 8; ++t) { const int h = h0 + t; float s = 0.f;
                    if (i <= j) s += Kn[((0 * 16 + (j - i)) * 16 + hp) * 16 + h];
                    if (i >= j) s += Kn[((1 * 16 + (i - j)) * 16 + hp) * 16 + h];
                    if (i == j && h == hp) s += dsk[h];
                    v[t] = s; }
            } else { const int kk = k0 - 256, d = kk >> 7, ri = (kk >> 6) & 1, p0 = kk & 63, e = d == 0 ? j + 1 : 16 - j;
#pragma unroll
                for (int t = 0; t < 8; ++t) { const int p = p0 + t; const float cr = cc[((d * 16 + hp) * 64 + p) * 2], ci = cc[((d * 16 + hp) * 64 + p) * 2 + 1], ar = pw[((d * 17 + e) * 64 + p) * 2], ai = pw[((d * 17 + e) * 64 + p) * 2 + 1];
                    v[t] = ri == 0 ? cr * ar - ci * ai : -(cr * ai + ci * ar); } }
            *(u32x4*)(W3 + (size_t)n * 512 + k0) = (u32x4){pk2(v[0], v[1]), pk2(v[2], v[3]), pk2(v[4], v[5]), pk2(v[6], v[7])};
        }
        for (int i = tid; i < 2 * 64; i += NT) { const int p = i & 63, d = i >> 6; A16[((size_t)it * 2 + d) * 128 + p * 2] = pw[((d * 17 + 16) * 64 + p) * 2]; A16[((size_t)it * 2 + d) * 128 + p * 2 + 1] = pw[((d * 17 + 16) * 64 + p) * 2 + 1]; }
        __syncthreads();
    }
}
typedef short bf16x8_t __attribute__((ext_vector_type(8)));
__device__ __forceinline__ void p_s5(const Args& a, const Bufs& B, const bf16* S5M, const float* A16, int l, LAS unsigned char* lds, int vcu, int G) {
    constexpr int XROW = 136;
    LAS bf16* XB = (LAS bf16*)lds;
    LAS bf16* XF = XB + 272 * XROW;
    LAS float* DX = (LAS float*)(lds + (272 + 32) * XROW * 2);
    const int tid = TIDX, lane = tid & 63, w = __builtin_amdgcn_readfirstlane(tid >> 6), l15 = lane & 15, lq = lane >> 4;
    for (int task = vcu; task < BATCH * S5G; task += G) {
        const int b = task / S5G, g = task % S5G;
        const bf16* W1 = S5M + (size_t)(l * S5G + g) * S5M_PER; const bf16* W3 = W1 + S5M_W1;
        const float* a16 = A16 + (size_t)(l * S5G + g) * 256;
        const bf16* Pu = B.P + g * 16 + 8 * (lq & 1);
#pragma unroll 1
        for (int sweep = 0; sweep < 2; ++sweep) {
            const int d = sweep == 0 ? 1 : 0;
            bf16x8_t bw[8];
#pragma unroll
            for (int ks = 0; ks < 8; ++ks) bw[ks] = *(const bf16x8_t*)(W1 + (size_t)(d * 128 + 16 * w + l15) * 256 + 32 * ks + 8 * lq);
            float xr = 0.f, xi = 0.f; const float ar = a16[d * 128 + (lane) * 2], ai = a16[d * 128 + (lane) * 2 + 1];
#pragma unroll 1
            for (int ti = 0; ti < 9; ++ti) {
                const int tile = d == 0 ? ti : (ti == 0 ? 0 : 9 - ti);
                const int c0 = tile == 0 ? 0 : 16 + 32 * (tile - 1), nch = tile == 0 ? 16 : 32;
                for (int mt = 0; mt < nch / 16; ++mt) {
                    const int ch = c0 + 16 * mt + l15; const int rb = ch < 16 ? b * CTX + 16 * ch : MC + b * SEQ + 16 * (ch - 16);
                    const bf16* up = Pu + (size_t)(rb + (lq >> 1)) * INC;
                    f32x4 acc = (f32x4){0.f, 0.f, 0.f, 0.f};
#pragma unroll
                    for (int ks = 0; ks < 8; ++ks) { const bf16x8_t av = *(const bf16x8_t*)(up + (size_t)(2 * ks) * INC); acc = __builtin_amdgcn_mfma_f32_16x16x32_bf16(av, bw[ks], acc, 0, 0, 0); }
#pragma unroll
                    for (int r = 0; r < 4; ++r) DX[(16 * mt + 4 * lq + r) * 132 + 16 * w + l15] = acc[r];
                }
                __syncthreads();
                if (w == 0) {
                    if (d == 0) { for (int cl = 0; cl < nch; ++cl) { XF[cl * XROW + lane] = f2bf(xr); XF[cl * XROW + 64 + lane] = f2bf(xi);
                            const float dr = DX[cl * 132 + lane], di = DX[cl * 132 + 64 + lane]; const float nr = ar * xr - ai * xi + dr, ni = ar * xi + ai * xr + di; xr = nr; xi = ni; } }
                    else { for (int cl = nch - 1; cl >= 0; --cl) { XB[(c0 + cl) * XROW + lane] = f2bf(xr); XB[(c0 + cl) * XROW + 64 + lane] = f2bf(xi);
                            const float dr = DX[cl * 132 + lane], di = DX[cl * 132 + 64 + lane]; const float nr = ar * xr - ai * xi + dr, ni = ar * xi + ai * xr + di; xr = nr; xi = ni; } }
                }
                __syncthreads();
                if (d == 0) {
                    f32x4 y[2][2];
#pragma unroll
                    for (int mt = 0; mt < 2; ++mt)
#pragma unroll
                        for (int nt = 0; nt < 2; ++nt) y[mt][nt] = (f32x4){0.f, 0.f, 0.f, 0.f};
                    const int nmt = nch / 16;
#pragma unroll 4
                    for (int ks = 0; ks < 16; ++ks) {
                        bf16x8_t bv[2];
#pragma unroll
                        for (int nt = 0; nt < 2; ++nt) bv[nt] = *(const bf16x8_t*)(W3 + (size_t)(32 * w + 16 * nt + l15) * 512 + 32 * ks + 8 * lq);
#pragma unroll
                        for (int mt = 0; mt < 2; ++mt) { if (mt < nmt) {
                            bf16x8_t av;
                            if (ks < 8) { const int ch = c0 + 16 * mt + l15; const int rb = ch < 16 ? b * CTX + 16 * ch : MC + b * SEQ + 16 * (ch - 16); av = *(const bf16x8_t*)(Pu + (size_t)(rb + (lq >> 1) + 2 * ks) * INC); }
                            else if (ks < 12) av = *(const LAS bf16x8_t*)(XF + (16 * mt + l15) * XROW + 32 * (ks - 8) + 8 * lq);
                            else av = *(const LAS bf16x8_t*)(XB + (c0 + 16 * mt + l15) * XROW + 32 * (ks - 12) + 8 * lq);
#pragma unroll
                            for (int nt = 0; nt < 2; ++nt) y[mt][nt] = __builtin_amdgcn_mfma_f32_16x16x32_bf16(av, bv[nt], y[mt][nt], 0, 0, 0); } }
                    }
#pragma unroll
                    for (int mt = 0; mt < 2; ++mt) { if (mt < nmt) {
#pragma unroll
                        for (int nt = 0; nt < 2; ++nt)
#pragma unroll
                            for (int r = 0; r < 4; ++r) { const int ch = c0 + 16 * mt + 4 * lq + r; const int rb = ch < 16 ? b * CTX + 16 * ch : MC + b * SEQ + 16 * (ch - 16);
                                B.S5Y[(size_t)(rb + 2 * w + nt) * S5W + g * 16 + l15] = f2bf(gelu_tanh(y[mt][nt][r])); } } }
                }
            }
        }
        __syncthreads();
    }
}

constexpr int GL_ST = 0, GL_QT = 34816, GL_QA = 43520, GL_KA = 52224, GL_KDT = 60928, GL_VT = 71168, GL_ATT = 81408, GL_DEC = 83968, GL_PART = 84480;
constexpr size_t GLS_S = 128 * 128, GLS_PER = GLS_S + 128;
__device__ __forceinline__ int gla_rowbase(int b, int d, int q) {
    if (q < 8) { const int qq = d ? 7 - q : q; return b * CTX + 32 * qq; }
    const int qq = d ? 127 - (q - 8) : (q - 8); return MC + b * SEQ + 32 * qq;
}
__device__ __forceinline__ float fexp(float x) { return __expf(x); }
template <bool FULL> __device__ __forceinline__ void gla_prep(const bf16* P, int rowbase, int hd, int d, float lbk, LAS unsigned char* lds, int tid, float& sumbend) {
    const int k = tid & 127, tg = tid >> 7;
    LAS float* PART = (LAS float*)(lds + GL_PART); LAS float* DEC = (LAS float*)(lds + GL_DEC);
    const bf16* pr = P + (size_t)(rowbase + 8 * tg) * INC + hd * HD + k;
    float lf[8], kk[8], vv[8], qq[8];
    float s = 0.f;
#pragma unroll
    for (int i = 0; i < 8; ++i) { const float raw = bf2f(pr[(size_t)i * INC + 512 + d * 512]); const float f = lbk + (1.f - lbk) * sigmoidf_(raw);
        lf[i] = fmaxf(__logf(f), -30.f); kk[i] = 1.f - f; s += lf[i]; vv[i] = bf2f(pr[(size_t)i * INC + 1536]); if (FULL) qq[i] = siluf_(bf2f(pr[(size_t)i * INC + 2048])); }
    PART[tg * 128 + k] = s;
    __syncthreads();
    const float p0 = PART[k], p1 = PART[128 + k], p2 = PART[256 + k], p3 = PART[384 + k];
    const float total = (p0 + p1) + (p2 + p3);
    float base, r;
    if (d == 0) { base = tg == 0 ? 0.f : (tg == 1 ? p0 : (tg == 2 ? p0 + p1 : p0 + p1 + p2)); r = p0 + p1; }
    else        { base = tg == 3 ? 0.f : (tg == 2 ? p3 : (tg == 1 ? p3 + p2 : p3 + p2 + p1)); r = p2 + p3; }
    float bc[8];
    if (d == 0) { float run = base;
#pragma unroll
        for (int i = 0; i < 8; ++i) { run += lf[i]; bc[i] = run; } }
    else { float run = base;
#pragma unroll
        for (int i = 7; i >= 0; --i) { run += lf[i]; bc[i] = run; } }
    { unsigned w[4];
#pragma unroll
      for (int q2 = 0; q2 < 4; ++q2) w[q2] = pk2(kk[2 * q2] * fexp(total - bc[2 * q2]), kk[2 * q2 + 1] * fexp(total - bc[2 * q2 + 1]));
      *(LAS u32x4*)(lds + GL_KDT + (k * 40 + 8 * tg) * 2) = (u32x4){w[0], w[1], w[2], w[3]};
#pragma unroll
      for (int q2 = 0; q2 < 4; ++q2) w[q2] = pk2(vv[2 * q2], vv[2 * q2 + 1]);
      *(LAS u32x4*)(lds + GL_VT + (k * 40 + 8 * tg) * 2) = (u32x4){w[0], w[1], w[2], w[3]}; }
    if (FULL) {
        LAS bf16* QT = (LAS bf16*)(lds + GL_QT); LAS bf16* QA = (LAS bf16*)(lds + GL_QA); LAS bf16* KA = (LAS bf16*)(lds + GL_KA);
#pragma unroll
        for (int i = 0; i < 8; ++i) { const int t = 8 * tg + i;
            QT[t * 136 + k] = f2bf(qq[i] * fexp(bc[i])); QA[t * 136 + k] = f2bf(qq[i] * fexp(fminf(bc[i] - r, 80.f))); KA[t * 136 + k] = f2bf(kk[i] * fexp(fminf(r - bc[i], 80.f))); }
    }
    if (tg == 0) { DEC[k] = fexp(total); sumbend += total; }
}
__device__ __forceinline__ void gla_update(f32x4 (&S)[8], LAS unsigned char* lds, int w, int l15, int lq, bool write_st) {
    const bf16x8_t bv = *(const LAS bf16x8_t*)(lds + GL_VT + ((16 * w + l15) * 40 + 8 * lq) * 2);
#pragma unroll
    for (int kt = 0; kt < 8; ++kt) {
        const bf16x8_t av = *(const LAS bf16x8_t*)(lds + GL_KDT + ((16 * kt + l15) * 40 + 8 * lq) * 2);
        const f32x4 dec = *(const LAS f32x4*)(lds + GL_DEC + (16 * kt + 4 * lq) * 4);
        S[kt] = __builtin_amdgcn_mfma_f32_16x16x32_bf16(av, bv, S[kt] * dec, 0, 0, 0);
        if (write_st) *(LAS u32x2*)(lds + GL_ST + ((16 * w + l15) * 136 + 16 * kt + 4 * lq) * 2) = (u32x2){pk2(S[kt][0], S[kt][1]), pk2(S[kt][2], S[kt][3])};
    }
}
__device__ __forceinline__ void p_gla_sum(const Args& a, const Bufs& B, float* GLS, int l, LAS unsigned char* lds, int first, int stride) {
    const int tid = TIDX, lane = tid & 63, w = __builtin_amdgcn_readfirstlane(tid >> 6), l15 = lane & 15, lq = lane >> 4;
    for (int task = first; task < 32 * 7; task += stride) {
        const int chain = task / 7, seg = task % 7, b = chain >> 3, hd = (chain >> 1) & 3, d = chain & 1;
        const float lbk = B.LB[(size_t)l * 2 * HGW + d * HGW + hd * HD + (tid & 127)];
        f32x4 S[8];
#pragma unroll
        for (int kt = 0; kt < 8; ++kt) S[kt] = (f32x4){0.f, 0.f, 0.f, 0.f};
        float sumbend = 0.f;
#pragma unroll 1
        for (int c = 0; c < 17; ++c) {
            gla_prep<false>(B.P, gla_rowbase(b, d, seg * 17 + c), hd, d, lbk, lds, tid, sumbend);
            __syncthreads();
            gla_update(S, lds, w, l15, lq, false);
            __syncthreads();
        }
        float* dst = GLS + (size_t)task * GLS_PER;
#pragma unroll
        for (int kt = 0; kt < 8; ++kt) *(f32x4*)(dst + ((size_t)(kt * 8 + w) * 64 + lane) * 4) = S[kt];
        if (tid < 128) dst[GLS_S + tid] = fexp(sumbend);
    }
}
__device__ __forceinline__ void p_gla_out(const Args& a, const Bufs& B, const float* GLS, int l, LAS unsigned char* lds, int first, int stride) {
    const int tid = TIDX, lane = tid & 63, w = __builtin_amdgcn_readfirstlane(tid >> 6), l15 = lane & 15, lq = lane >> 4;
    for (int task = first; task < 32 * 8; task += stride) {
        const int chain = task >> 3, seg = task & 7, b = chain >> 3, hd = (chain >> 1) & 3, d = chain & 1;
        const float lbk = B.LB[(size_t)l * 2 * HGW + d * HGW + hd * HD + (tid & 127)];
        bf16* O = d ? B.OB : B.OF;
        f32x4 S[8];
#pragma unroll
        for (int kt = 0; kt < 8; ++kt) S[kt] = (f32x4){0.f, 0.f, 0.f, 0.f};
        for (int sp = 0; sp < seg; ++sp) {
            const float* src = GLS + (size_t)(chain * 7 + sp) * GLS_PER;
#pragma unroll
            for (int kt = 0; kt < 8; ++kt) { const f32x4 dv = *(const f32x4*)(src + GLS_S + 16 * kt + 4 * lq); S[kt] = S[kt] * dv + *(const f32x4*)(src + ((size_t)(kt * 8 + w) * 64 + lane) * 4); }
        }
#pragma unroll
        for (int kt = 0; kt < 8; ++kt) *(LAS u32x2*)(lds + GL_ST + ((16 * w + l15) * 136 + 16 * kt + 4 * lq) * 2) = (u32x2){pk2(S[kt][0], S[kt][1]), pk2(S[kt][2], S[kt][3])};
        float sumbend = 0.f;
#pragma unroll 1
        for (int c = 0; c < 17; ++c) {
            const int rowbase = gla_rowbase(b, d, seg * 17 + c);
            gla_prep<true>(B.P, rowbase, hd, d, lbk, lds, tid, sumbend);
            __syncthreads();
            if (w < 4) {
                const int mt = w >> 1, nt = w & 1; f32x4 acc = (f32x4){0.f, 0.f, 0.f, 0.f};
#pragma unroll
                for (int ks = 0; ks < 4; ++ks) { const bf16x8_t av = *(const LAS bf16x8_t*)(lds + GL_QA + ((16 * mt + l15) * 136 + 32 * ks + 8 * lq) * 2);
                    const bf16x8_t bv = *(const LAS bf16x8_t*)(lds + GL_KA + ((16 * nt + l15) * 136 + 32 * ks + 8 * lq) * 2); acc = __builtin_amdgcn_mfma_f32_16x16x32_bf16(av, bv, acc, 0, 0, 0); }
                LAS bf16* ATT = (LAS bf16*)(lds + GL_ATT);
#pragma unroll
                for (int r = 0; r < 4; ++r) { const int i = 16 * mt + 4 * lq + r, j = 16 * nt + l15; const bool ok = d ? (j >= i) : (j <= i); ATT[i * 40 + j] = f2bf(ok ? acc[r] : 0.f); }
            }
            __syncthreads();
            {
                f32x4 o[2] = {(f32x4){0.f, 0.f, 0.f, 0.f}, (f32x4){0.f, 0.f, 0.f, 0.f}};
#pragma unroll
                for (int ks = 0; ks < 4; ++ks) { const bf16x8_t bv = *(const LAS bf16x8_t*)(lds + GL_ST + ((16 * w + l15) * 136 + 32 * ks + 8 * lq) * 2);
#pragma unroll
                    for (int mt = 0; mt < 2; ++mt) { const bf16x8_t av = *(const LAS bf16x8_t*)(lds + GL_QT + ((16 * mt + l15) * 136 + 32 * ks + 8 * lq) * 2); o[mt] = __builtin_amdgcn_mfma_f32_16x16x32_bf16(av, bv, o[mt], 0, 0, 0); } }
                const bf16x8_t vb = *(const LAS bf16x8_t*)(lds + GL_VT + ((16 * w + l15) * 40 + 8 * lq) * 2);
#pragma unroll
                for (int mt = 0; mt < 2; ++mt) { const bf16x8_t av = *(const LAS bf16x8_t*)(lds + GL_ATT + ((16 * mt + l15) * 40 + 8 * lq) * 2); o[mt] = __builtin_amdgcn_mfma_f32_16x16x32_bf16(av, vb, o[mt], 0, 0, 0); }
#pragma unroll
                for (int mt = 0; mt < 2; ++mt)
#pragma unroll
                    for (int r = 0; r < 4; ++r) O[(size_t)(rowbase + 16 * mt + 4 * lq + r) * HGW + hd * HD + 16 * w + l15] = f2bf(o[mt][r]);
            }
            gla_update(S, lds, w, l15, lq, true);
            __syncthreads();
        }
    }
}

#undef TIDX
__global__ void __launch_bounds__(NT, 2) mk_fwd(Args args) {
    extern __shared__ __attribute__((aligned(16))) unsigned char lds_raw[];
    LAS unsigned char* lds = (LAS unsigned char*)lds_raw;
    volatile LAS unsigned* MISC = (volatile LAS unsigned*)(lds + MISC_OFF);
    const int G = gridDim.x; const int bx = blockIdx.x; const int vcu = (G % 8 == 0) ? (bx % 8) * (G / 8) + bx / 8 : bx;
    unsigned char* ws = args.ws;
    Bufs B;
    B.MOD = (float*)(ws + WS_MISC); B.LB = B.MOD + DEPTH * 5 * 6 * D; B.AB = B.LB + DEPTH * 2 * HGW; B.BB = B.AB + DEPTH * 2 * S5G * S5P * 2;
    B.XC = (float*)(ws + WS_XC);
    B.WIN = (bf16*)(ws + WS_WIN); B.WGLU = (bf16*)(ws + WS_WGLU); B.WOUT = (bf16*)(ws + WS_WOUT); B.WUP = (bf16*)(ws + WS_WUP); B.WDN = (bf16*)(ws + WS_WDN);
    B.H = (bf16*)(ws + WS_H); B.P = (bf16*)(ws + WS_P); B.ACT = (bf16*)(ws + WS_ACT);
    B.OF = (bf16*)(ws + WS_OFB); B.OB = B.OF + (size_t)M * HGW;
    B.S5Y = (bf16*)(ws + WS_S5Y); B.Y = (bf16*)(ws + WS_Y); B.S5M = (bf16*)(ws + WS_S5M); B.A16 = B.BB + DEPTH * 2 * S5G * S5P * S5H * 2;
    for (int u = threadIdx.x; u < (HALO_OFF - LDSCTL_OFF) / 4; u += NT) ((LAS unsigned*)(lds + LDSCTL_OFF))[u] = 0u;
    __syncthreads();
    XcdBarrier bar = xcd_barrier_post((unsigned*)(ws + WS_CTL) + CW_BAR, MISC + 8);
#define GRID_BAR() xcd_barrier(bar)

    p_mod(args, B, lds, vcu, G);
    p_small(args, B, vcu, G);
    p_wprep(args, B, lds, vcu, G);
    p_s5mats(args, B.S5M, B.A16, lds, vcu, G);
    GRID_BAR();
    p_modulate(args, B, B.MOD, 0, D, vcu, G);
    GRID_BAR();
    for (int l = 0; l < DEPTH; ++l) {
        const float* modl = B.MOD + (size_t)l * 5 * 6 * D;
        { pg8::Gemm g{B.H, B.WIN + (size_t)l * INC * D, M, INC, D}; pg8::StaticOrder S; S.init(M, INC, G, bx); pg8::EpiBf16Plain E{B.P, INC};
          pg8::gemm_phase<pg8::EpiBf16Plain, pg8::StaticOrder, true, true>(lds, g, S, E); }
        GRID_BAR();
        if (vcu < 128) p_s5(args, B, B.S5M, B.A16, l, lds, vcu, 128); else p_gla_sum(args, B, (float*)B.Y, l, lds, vcu - 128, G - 128);
        GRID_BAR();
        p_gla_out(args, B, (const float*)B.Y, l, lds, vcu, G);
        GRID_BAR();
        p_mixout(args, B, l, lds, vcu, G);
        GRID_BAR();
        { pg8::Gemm g{B.S5Y, B.WGLU + (size_t)l * S5W * S5W, M, S5W, S5W}; pg8::StaticOrder S; S.init(M, S5W, G, bx); pg8::EpiGlu E{B.Y, B.S5Y, args.in[I_BGLU] + (size_t)l * S5W};
          pg8::gemm_phase<pg8::EpiGlu, pg8::StaticOrder, true, true>(lds, g, S, E); }
        GRID_BAR();
        { pg8::Gemm g{B.Y, B.WOUT + (size_t)l * D * D, M, D, D}; pg8::StaticOrder S; S.init(M, D, G, bx); pg8::EpiResid E{B.XC, args.out, modl, 2 * D};
          pg8::gemm_phase<pg8::EpiResid, pg8::StaticOrder, true, true>(lds, g, S, E); }
        GRID_BAR();
        p_ln(args, B, args.in[I_LN1G] + (size_t)l * D, args.in[I_LN1B] + (size_t)l * D, modl, 3 * D, 4 * D, vcu, G);
        GRID_BAR();
        { pg8::Gemm g{B.H, B.WUP + (size_t)l * 2 * DFF * D, M, 2 * DFF, D}; pg8::StaticOrder S; S.init(M, 2 * DFF, G, bx);
          pg8::EpiUpConv E{B.ACT, args.in[I_CONVW] + (size_t)l * 3 * 2 * DFF, args.in[I_CONVB] + (size_t)l * 2 * DFF, B.H, B.WUP + (size_t)l * 2 * DFF * D, (LAS float*)(lds + HALO_OFF)};
          pg8::gemm_phase<pg8::EpiUpConv, pg8::StaticOrder, true, true>(lds, g, S, E); }
        GRID_BAR();
        { pg8::Gemm g{B.ACT, B.WDN + (size_t)l * D * DFF, M, D, DFF}; pg8::StaticOrder S; S.init(M, D, G, bx); pg8::EpiResid E{B.XC, args.out, modl, 5 * D};
          pg8::gemm_phase<pg8::EpiResid, pg8::StaticOrder, true, true>(lds, g, S, E); }
        GRID_BAR();
        p_ln(args, B, args.in[I_LN2G] + (size_t)l * D, args.in[I_LN2B] + (size_t)l * D, l + 1 < DEPTH ? modl + 5 * 6 * D : nullptr, 0, D, vcu, G);
        if (l + 1 < DEPTH) GRID_BAR();
    }
}

extern "C" void kernel_launch(void* const* d_in, const int* in_sizes, int n_in, void* d_out, int out_size, void* d_ws, size_t ws_size, hipStream_t stream) {
    static int grid = 0;
    if (grid == 0) {
        if (n_in != N_IN || out_size != MX * D || ws_size < WS_END) { fprintf(stderr, "kernel_launch: unexpected shapes (n_in %d out %d ws %zu)\n", n_in, out_size, ws_size); grid = -1; return; }
        int dev = 0, cus = 0, per_cu = 0;
        if (hipGetDevice(&dev) != hipSuccess || hipDeviceGetAttribute(&cus, hipDeviceAttributeMultiprocessorCount, dev) != hipSuccess) { grid = -1; return; }
        if (hipFuncSetAttribute((const void*)mk_fwd, hipFuncAttributeMaxDynamicSharedMemorySize, LDS_BYTES) != hipSuccess) { fprintf(stderr, "kernel_launch: hipFuncSetAttribute failed\n"); grid = -1; return; }
        if (hipOccupancyMaxActiveBlocksPerMultiprocessor(&per_cu, (const void*)mk_fwd, NT, LDS_BYTES) != hipSuccess || per_cu < 1) { fprintf(stderr, "kernel_launch: occupancy query says %d blocks/CU\n", per_cu); per_cu = 1; }
        (void)hipGetLastError();
        grid = cus;
    }
    if (grid < 0) return;
    if (hipMemsetAsync((char*)d_ws + WS_CTL, 0, CTL_ZERO_BYTES, stream) != hipSuccess) return;
    Args a{};
    for (int i = 0; i < N_IN; ++i) a.in[i] = (const float*)d_in[i];
    a.out = (float*)d_out; a.ws = (unsigned char*)d_ws;
    hipLaunchKernelGGL(mk_fwd, dim3(grid), dim3(NT), LDS_BYTES, stream, a);
}
```

```cpp
#include <hip/hip_runtime.h>
#include <cstdio>
#include <cstdint>

constexpr int D = 1024, BATCH = 4, SEQ = 4096, DEPTH = 4, CTX = 256;
constexpr int S5W = 512, S5G = 32, S5H = 16, S5P = 64, HGW = 512, HD = 128, NH = 4;
constexpr int DFF = 2816, INC = 3072;
constexpr int MC = BATCH * CTX;
constexpr int MX = BATCH * SEQ;
constexpr int M = MC + MX;
constexpr float ALPHA = 1.681792830507429f;
constexpr float LN_EPS = 1e-5f, RMS_EPS = 1e-6f;

enum { I_X = 0, I_C, I_CTX, I_CCTX, I_WMOD, I_BMOD, I_WIN, I_LRE, I_LIM, I_LDT, I_BRE, I_BIM, I_CRE, I_CIM, I_SD, I_WGLU, I_BGLU,
       I_HGLB, I_HGNW, I_WOUT, I_LN1G, I_LN1B, I_WUP, I_CONVW, I_CONVB, I_WDOWN, I_LN2G, I_LN2B, N_IN };

typedef unsigned short bf16;
__device__ __forceinline__ float sigmoidf_(float x) { return 1.f / (1.f + __expf(-x)); }
__device__ __forceinline__ float siluf_(float x) { return x / (1.f + __expf(-x)); }
__device__ __forceinline__ float gelu_tanh(float x) { const float u = 0.7978845608028654f * (x + 0.044715f * x * x * x); return 0.5f * x * (1.f + tanhf(u)); }
__device__ __forceinline__ float bf2f(bf16 b) { return __uint_as_float(((unsigned)b) << 16); }
__device__ __forceinline__ bf16 f2bf(float f) { unsigned u = __float_as_uint(f); return (bf16)((u + 0x7fffu + ((u >> 16) & 1u)) >> 16); }
__host__ __device__ __forceinline__ int row_modidx(int r) { return r < MC ? 4 : (r - MC) / SEQ; }

namespace pg8 {
#define PG8_LAS __attribute__((address_space(3)))
typedef unsigned short bf16_t;
typedef short bf16x8 __attribute__((ext_vector_type(8)));
typedef float f32x4 __attribute__((ext_vector_type(4)));
typedef unsigned u32x4 __attribute__((ext_vector_type(4)));
constexpr int BM = 256, BK = 64, HALF = 128, HTB = HALF * BK * 2  , STAGE_BYTES = 8 * HTB, NXCD = 8, WGM = 8;

__host__ __device__ __forceinline__ int lds_byte(int r, int c) { const int st = (r >> 4) * 2 + (c >> 5), rr = r & 15, cc = c & 31, ob = rr * 64 + cc * 2; return st * 1024 + (ob ^ (((ob >> 9) & 1) << 5)); }
__host__ __device__ __forceinline__ void stage_rc(int b, int& R, int& C) { const int st = b / 1024, sb = b % 1024, swz = sb ^ (((sb >> 9) & 1) << 5); R = (st >> 1) * 16 + swz / 64; C = (st & 1) * 32 + (swz % 64) / 2; }
__host__ __device__ __forceinline__ int perm32(int rho) { const int n = rho >> 4, i = rho & 15; return 8 * (i >> 2) + 4 * n + (i & 3); }

struct Unit { int pm, pn; };
struct Gemm { const bf16_t* A; const bf16_t* Bt; int M, N, K, pad; };

struct StaticOrder {
    int nM, nN, nwg, G, c;
    __host__ __device__ void init(int M, int N, int G_, int c_) { nM = M / BM; nN = N / BM; nwg = nM * nN; G = G_; c = c_; }
    __host__ __device__ bool next(int i, Unit& u) const {
        const long L = (long)i * G + c; if (L >= nwg) return false;
        int wgid = (int)L; { const int q = nwg / NXCD, r = nwg % NXCD, xcd = wgid % NXCD, off = wgid / NXCD; wgid = (xcd < r ? xcd * (q + 1) : r * (q + 1) + (xcd - r) * q) + off; }
        const int nig = WGM * nN, gid = wgid / nig, fm = gid * WGM, gsz = (nM - fm) < WGM ? (nM - fm) : WGM;
        u.pm = fm + ((wgid % nig) % gsz); u.pn = (wgid % nig) / gsz; return true;
    }
    __device__ __forceinline__ void a_ready(const Unit&) const {}
    __device__ __forceinline__ void done(const Unit&) const {}
};
constexpr int DFF_ = 2816;
__device__ __forceinline__ unsigned cvt_pk_bf16(float lo, float hi) { unsigned r; asm volatile("v_cvt_pk_bf16_f32 %0, %1, %2" : "=v"(r) : "v"(lo), "v"(hi)); return r; }
typedef unsigned u32x2 __attribute__((ext_vector_type(2)));
__device__ __forceinline__ float bflo(unsigned w) { return __uint_as_float(w << 16); }
__device__ __forceinline__ float bfhi(unsigned w) { return __uint_as_float(w & 0xffff0000u); }
__device__ __forceinline__ float sigm(float x) { return __builtin_amdgcn_rcpf(1.f + __expf(-x)); }

struct EpiBf16Plain {
    static constexpr bool PERM = true, AFTER_DRAIN = false;
    bf16_t* O; int ldc, pad;
    __device__ __forceinline__ void operator()(const f32x4 (&acc)[2][2][4][2], const Unit& u, int wr, int wc, int fr, int fq) const {
        const int row0 = u.pm * BM + wr * 64 + fr, col0 = u.pn * BM + wc * 32 + 8 * fq;
#pragma unroll
        for (int ai = 0; ai < 2; ++ai)
#pragma unroll
            for (int m = 0; m < 4; ++m) { bf16_t* rowp = O + (size_t)(row0 + ai * HALF + m * 16) * ldc + col0;
#pragma unroll
                for (int bj = 0; bj < 2; ++bj) { const f32x4 v0 = acc[ai][bj][m][0], v1 = acc[ai][bj][m][1];
                    u32x4 w; w.x = cvt_pk_bf16(v0[0], v0[1]); w.y = cvt_pk_bf16(v0[2], v0[3]); w.z = cvt_pk_bf16(v1[0], v1[1]); w.w = cvt_pk_bf16(v1[2], v1[3]);
                    *(u32x4*)(rowp + bj * HALF) = w; } }
    }
};
struct EpiGlu {
    static constexpr bool PERM = true, AFTER_DRAIN = false;
    bf16_t* Y; const bf16_t* S5Y; const float* bias;
    __device__ __forceinline__ void operator()(const f32x4 (&acc)[2][2][4][2], const Unit& u, int wr, int wc, int fr, int fq) const {
        const int row0 = u.pm * BM + wr * 64 + fr, col0 = u.pn * BM + wc * 32 + 8 * fq;
        f32x4 bv[2][2];
#pragma unroll
        for (int bj = 0; bj < 2; ++bj)
#pragma unroll
            for (int n = 0; n < 2; ++n) bv[bj][n] = *(const f32x4*)(bias + col0 + bj * HALF + 4 * n);
#pragma unroll
        for (int ai = 0; ai < 2; ++ai)
#pragma unroll
            for (int m = 0; m < 4; ++m) { const size_t row = (size_t)(row0 + ai * HALF + m * 16);
#pragma unroll
                for (int bj = 0; bj < 2; ++bj) { const f32x4 v0 = acc[ai][bj][m][0] + bv[bj][0], v1 = acc[ai][bj][m][1] + bv[bj][1];
                    const u32x4 s = *(const u32x4*)(S5Y + row * 512 + col0 + bj * HALF);
                    u32x4 w;
                    w.x = cvt_pk_bf16(bflo(s.x) * sigm(v0[0]), bfhi(s.x) * sigm(v0[1])); w.y = cvt_pk_bf16(bflo(s.y) * sigm(v0[2]), bfhi(s.y) * sigm(v0[3]));
                    w.z = cvt_pk_bf16(bflo(s.z) * sigm(v1[0]), bfhi(s.z) * sigm(v1[1])); w.w = cvt_pk_bf16(bflo(s.w) * sigm(v1[2]), bfhi(s.w) * sigm(v1[3]));
                    *(u32x4*)(Y + row * 1024 + col0 + bj * HALF) = w; } }
    }
};
struct EpiResid {
    static constexpr bool PERM = false, AFTER_DRAIN = false;
    float* XC; float* XO; const float* modl; int off_gate, pad;
    __device__ __forceinline__ void operator()(const f32x4 (&acc)[2][2][4][2], const Unit& u, int wr, int wc, int fr, int fq) const {
        float* xb = u.pm < 4 ? XC + (size_t)u.pm * BM * 1024 : XO + (size_t)(u.pm - 4) * BM * 1024;
        const float* gate = modl + (size_t)(u.pm < 4 ? 4 : (u.pm - 4) >> 4) * 6144 + off_gate;
        const int rl0 = wr * 64 + fr, col0 = u.pn * BM + wc * 32 + 4 * fq;
        f32x4 gv[2][2];
#pragma unroll
        for (int bj = 0; bj < 2; ++bj)
#pragma unroll
            for (int n = 0; n < 2; ++n) gv[bj][n] = *(const f32x4*)(gate + col0 + bj * HALF + n * 16);
#pragma unroll
        for (int ai = 0; ai < 2; ++ai)
#pragma unroll
            for (int m = 0; m < 4; ++m) { float* rowp = xb + (size_t)(rl0 + ai * HALF + m * 16) * 1024 + col0;
#pragma unroll
                for (int bj = 0; bj < 2; ++bj)
#pragma unroll
                    for (int n = 0; n < 2; ++n) { f32x4* p = (f32x4*)(rowp + bj * HALF + n * 16); const f32x4 x = *p; *p = x * 1.681792830507429f + gv[bj][n] * acc[ai][bj][m][n]; }
                asm volatile("" ::: "memory"); }
    }
};
template <int CTRL> __device__ __forceinline__ float dpp_f(float x) { return __builtin_bit_cast(float, __builtin_amdgcn_update_dpp(0, __builtin_bit_cast(int, x), CTRL, 0xf, 0xf, false)); }
__device__ __forceinline__ f32x4 ror1(f32x4 v) { return (f32x4){dpp_f<0x121>(v[0]), dpp_f<0x121>(v[1]), dpp_f<0x121>(v[2]), dpp_f<0x121>(v[3])}; }
__device__ __forceinline__ f32x4 rol1(f32x4 v) { return (f32x4){dpp_f<0x12F>(v[0]), dpp_f<0x12F>(v[1]), dpp_f<0x12F>(v[2]), dpp_f<0x12F>(v[3])}; }
struct EpiUpConv {
    static constexpr bool PERM = true, AFTER_DRAIN = false;
    bf16_t* ACT; const float* cw; const float* cb; PG8_LAS float* ex; int pad;
    __device__ __forceinline__ void operator()(const f32x4 (&acc)[2][2][4][2], const Unit& u, int wr, int wc, int fr, int fq) const {
        const bool isctx = u.pm < 4;
        const int ocol = u.pn * HALF + wc * 32 + 8 * fq;
        if (isctx) {
            const int xc = wc * 32 + 8 * fq;
            if (fr == 0) {
#pragma unroll
                for (int ai = 0; ai < 2; ++ai)
#pragma unroll
                    for (int bj = 0; bj < 2; ++bj)
#pragma unroll
                        for (int n = 0; n < 2; ++n) *(PG8_LAS f32x4*)(ex + ((2 * ai + wr) * 2 + 0) * 256 + bj * HALF + xc + 4 * n) = acc[ai][bj][0][n];
            }
            if (fr == 15) {
#pragma unroll
                for (int ai = 0; ai < 2; ++ai)
#pragma unroll
                    for (int bj = 0; bj < 2; ++bj)
#pragma unroll
                        for (int n = 0; n < 2; ++n) *(PG8_LAS f32x4*)(ex + ((2 * ai + wr) * 2 + 1) * 256 + bj * HALF + xc + 4 * n) = acc[ai][bj][3][n];
            }
            asm volatile("s_waitcnt lgkmcnt(0)" ::: "memory"); __builtin_amdgcn_s_barrier(); asm volatile("" ::: "memory");
        }
        const int row0 = u.pm * BM + wr * 64 + fr;
        u32x2 pk[2][4];
#pragma unroll
        for (int n = 0; n < 2; ++n) {
            f32x4 w0[2], w1[2], w2[2], bb[2];
#pragma unroll
            for (int bj = 0; bj < 2; ++bj) { const int oc = bj * DFF_ + ocol + 4 * n;
                w0[bj] = *(const f32x4*)(cw + oc); w1[bj] = *(const f32x4*)(cw + 2 * DFF_ + oc); w2[bj] = *(const f32x4*)(cw + 4 * DFF_ + oc); bb[bj] = *(const f32x4*)(cb + oc); }
#pragma unroll
            for (int ai = 0; ai < 2; ++ai) {
                const int blk = 2 * ai + wr;
                f32x4 tp[2], sc[2], hn[2];
#pragma unroll
                for (int bj = 0; bj < 2; ++bj) { tp[bj] = (f32x4){0.f, 0.f, 0.f, 0.f}; hn[bj] = (f32x4){0.f, 0.f, 0.f, 0.f};
                    if (isctx) { const int xo = bj * HALF + wc * 32 + 8 * fq + 4 * n;
                        if (blk > 0) tp[bj] = *(const PG8_LAS f32x4*)(ex + ((blk - 1) * 2 + 1) * 256 + xo);
                        if (blk < 3) hn[bj] = *(const PG8_LAS f32x4*)(ex + ((blk + 1) * 2 + 0) * 256 + xo); }
                    sc[bj] = rol1(acc[ai][bj][0][n]); }
#pragma unroll
                for (int m = 0; m < 4; ++m) {
                    f32x4 o[2];
#pragma unroll
                    for (int bj = 0; bj < 2; ++bj) {
                        const f32x4 cur = acc[ai][bj][m][n];
                        const f32x4 t = ror1(cur);
                        const f32x4 sn = m < 3 ? rol1(acc[ai][bj][m < 3 ? m + 1 : 3][n]) : hn[bj];
                        const f32x4 pv = fr != 0 ? t : tp[bj];
                        const f32x4 nv = fr != 15 ? sc[bj] : sn;
                        tp[bj] = t; sc[bj] = sn;
                        o[bj] = bb[bj] + w0[bj] * pv + w1[bj] * cur + w2[bj] * nv;
                    }
                    const f32x4 a = o[0], g = o[1]; u32x2 w; w.x = cvt_pk_bf16(a[0] * sigm(a[0]) * g[0], a[1] * sigm(a[1]) * g[1]); w.y = cvt_pk_bf16(a[2] * sigm(a[2]) * g[2], a[3] * sigm(a[3]) * g[3]);
                    if (n == 0) pk[ai][m] = w;
                    else *(u32x4*)(ACT + (size_t)(row0 + ai * HALF + m * 16) * DFF_ + ocol) = (u32x4){pk[ai][m].x, pk[ai][m].y, w.x, w.y};
                }
            }
        }
    }
};

template <class Epi, class Sched, bool ALIGN_EPI = false, bool SP2 = false>
__device__ __forceinline__ void gemm_phase(PG8_LAS unsigned char* lds, const Gemm g, const Sched& S, const Epi& E) {
    int tid_ = threadIdx.x; asm volatile("" : "+v"(tid_));
    const int tid = tid_, wid = __builtin_amdgcn_readfirstlane(tid >> 6), lane = tid & 63, wr = wid >> 2, wc = wid & 3, fr = lane & 15, fq = lane >> 4;
    const int K = g.K, nt = K / BK;
    unsigned voffA[2], voffB[2];
#pragma unroll
    for (int i = 0; i < 2; ++i) { int R, C; stage_rc(tid * 16 + i * 8192, R, C); const int Rb = Epi::PERM ? ((R & ~31) + perm32(R & 31)) : R;
        voffA[i] = (unsigned)(R * K + C) * 2u; voffB[i] = (unsigned)(Rb * K + C) * 2u; }
    const size_t kstep = (size_t)(BK * 2);
    const size_t hstep = (size_t)HALF * K * 2;
    const size_t tstep = 2 * hstep;
    const unsigned ldsw = (unsigned)wid * 1024u;
    const int aoff = lds_byte(wr * 64 + fr, fq * 8), boff = lds_byte(wc * 32 + fr, fq * 8);
#define PG8_SA(b, h) (((b) * 2 + (h)) * HTB)
#define PG8_SB(b, h) ((4 + (b) * 2 + (h)) * HTB)
#define PG8_STAGE(bufoff, gbase, voff) do { _Pragma("unroll") for (int _i = 0; _i < 2; ++_i) \
        __builtin_amdgcn_global_load_lds((const unsigned*)((const char*)(gbase) + (voff)[_i]), (PG8_LAS unsigned*)(lds + (bufoff) + ldsw + _i * 8192), 16, 0, 0); } while (0)
#define PG8_LDA(dst, b, h) do { _Pragma("unroll") for (int m = 0; m < 4; ++m) _Pragma("unroll") for (int k = 0; k < 2; ++k) dst[m][k] = *(const PG8_LAS bf16x8*)(lds + PG8_SA(b, h) + aoff + m * 2048 + k * 1024); } while (0)
#define PG8_LDB(dst, b, h) do { _Pragma("unroll") for (int n = 0; n < 2; ++n) _Pragma("unroll") for (int k = 0; k < 2; ++k) dst[n][k] = *(const PG8_LAS bf16x8*)(lds + PG8_SB(b, h) + boff + n * 2048 + k * 1024); } while (0)
#define PG8_MMA(ai, bj, At, Bt) do { __builtin_amdgcn_s_setprio(1); _Pragma("unroll") for (int m = 0; m < 4; ++m) _Pragma("unroll") for (int n = 0; n < 2; ++n) _Pragma("unroll") for (int k = 0; k < 2; ++k) \
        acc[ai][bj][m][n] = __builtin_amdgcn_mfma_f32_16x16x32_bf16(Bt[n][k], At[m][k], acc[ai][bj][m][n], 0, 0, 0); __builtin_amdgcn_s_setprio(0); } while (0)
#define PG8_WAIT_V(n) asm volatile("s_waitcnt vmcnt(" #n ")" ::: "memory")
#define PG8_WAIT_L(n) asm volatile("s_waitcnt lgkmcnt(" #n ")" ::: "memory")
#define PG8_BAR __builtin_amdgcn_s_barrier()
#define PG8_SCHED __builtin_amdgcn_sched_barrier(0)
    Unit cur, nxt; int ui = 0;
    if (!S.next(0, cur)) return;
    f32x4 acc[2][2][4][2];
#pragma unroll
    for (int a = 0; a < 2; ++a)
#pragma unroll
        for (int b = 0; b < 2; ++b)
#pragma unroll
            for (int m = 0; m < 4; ++m)
#pragma unroll
                for (int n = 0; n < 2; ++n) acc[a][b][m][n] = (f32x4){0.f, 0.f, 0.f, 0.f};
    bf16x8 At[4][2], B0[2][2], B1[2][2];
    const char* cA = (const char*)g.A + (size_t)cur.pm * tstep; const char* cB = (const char*)g.Bt + (size_t)cur.pn * tstep;
    S.a_ready(cur);
    if constexpr (SP2) {
        PG8_STAGE(PG8_SB(0, 0), cB, voffB); PG8_STAGE(PG8_SB(0, 1), cB + hstep, voffB); PG8_STAGE(PG8_SA(0, 0), cA, voffA); PG8_STAGE(PG8_SA(0, 1), cA + hstep, voffA);
        if (wr == 1) PG8_BAR;
        PG8_WAIT_V(2); PG8_BAR;
        PG8_STAGE(PG8_SB(1, 0), cB + kstep, voffB); PG8_STAGE(PG8_SA(1, 0), cA + kstep, voffA); PG8_STAGE(PG8_SB(1, 1), cB + hstep + kstep, voffB);
        PG8_WAIT_V(6); PG8_BAR;
    } else {
        PG8_STAGE(PG8_SB(0, 0), cB, voffB); PG8_STAGE(PG8_SA(0, 0), cA, voffA); PG8_STAGE(PG8_SB(0, 1), cB + hstep, voffB); PG8_STAGE(PG8_SA(0, 1), cA + hstep, voffA);
        if (wr == 1) PG8_BAR;
        PG8_WAIT_V(4); PG8_BAR;
        PG8_STAGE(PG8_SB(1, 0), cB + kstep, voffB); PG8_STAGE(PG8_SA(1, 0), cA + kstep, voffA); PG8_STAGE(PG8_SB(1, 1), cB + hstep + kstep, voffB);
        PG8_WAIT_V(6); PG8_BAR;
    }
    for (;;) {
        const bool has_next = S.next(ui + 1, nxt);
        const char* nA = has_next ? (const char*)g.A + (size_t)nxt.pm * tstep : cA; const char* nB = has_next ? (const char*)g.Bt + (size_t)nxt.pn * tstep : cB;
        for (int t = 0; t < nt; t += 2) {
            const bool last = (t == nt - 2);
            const char* a1 = cA + (size_t)(t + 1) * kstep;
            const char* a2 = last ? nA : cA + (size_t)(t + 2) * kstep; const char* b2 = last ? nB : cB + (size_t)(t + 2) * kstep;
            const char* a3 = a2 + kstep; const char* b3 = b2 + kstep;
            if (last && has_next) S.a_ready(nxt);
            if constexpr (SP2) {
            PG8_LDB(B0, 0, 0); PG8_LDB(B1, 0, 1); PG8_SCHED; PG8_LDA(At, 0, 0); PG8_STAGE(PG8_SA(1, 1), a1 + hstep, voffA);
            PG8_WAIT_V(8); PG8_WAIT_L(0); PG8_BAR; PG8_MMA(0, 0, At, B0); PG8_MMA(0, 1, At, B1); PG8_BAR; PG8_SCHED;
            PG8_LDA(At, 0, 1); PG8_STAGE(PG8_SB(0, 0), b2, voffB); PG8_STAGE(PG8_SB(0, 1), b2 + hstep, voffB); PG8_STAGE(PG8_SA(0, 0), a2, voffA);
            PG8_WAIT_V(8); PG8_WAIT_L(0); PG8_BAR; PG8_MMA(1, 0, At, B0); PG8_MMA(1, 1, At, B1); PG8_BAR; PG8_SCHED;
            PG8_LDB(B0, 1, 0); PG8_LDB(B1, 1, 1); PG8_SCHED; PG8_LDA(At, 1, 0); PG8_STAGE(PG8_SA(0, 1), a2 + hstep, voffA);
            PG8_WAIT_V(8); PG8_WAIT_L(0); PG8_BAR; PG8_MMA(0, 0, At, B0); PG8_MMA(0, 1, At, B1); PG8_BAR; PG8_SCHED;
            PG8_LDA(At, 1, 1); PG8_STAGE(PG8_SB(1, 0), b3, voffB); PG8_STAGE(PG8_SB(1, 1), b3 + hstep, voffB); PG8_STAGE(PG8_SA(1, 0), a3, voffA);
            PG8_WAIT_V(8); PG8_WAIT_L(0); PG8_BAR; PG8_MMA(1, 0, At, B0); PG8_MMA(1, 1, At, B1); PG8_BAR; PG8_SCHED;
            } else {
            PG8_LDB(B0, 0, 0); PG8_SCHED; PG8_LDA(At, 0, 0); PG8_STAGE(PG8_SA(1, 1), a1 + hstep, voffA);
            PG8_WAIT_L(8); PG8_BAR; PG8_WAIT_L(0); PG8_MMA(0, 0, At, B0); PG8_BAR; PG8_SCHED;
            PG8_LDB(B1, 0, 1); PG8_STAGE(PG8_SB(0, 0), b2, voffB);
            PG8_BAR; PG8_WAIT_L(0); PG8_MMA(0, 1, At, B1); PG8_BAR;
            PG8_LDA(At, 0, 1); PG8_STAGE(PG8_SA(0, 0), a2, voffA);
            PG8_BAR; PG8_WAIT_L(0); PG8_MMA(1, 0, At, B0); PG8_BAR; PG8_SCHED;
            PG8_STAGE(PG8_SB(0, 1), b2 + hstep, voffB);
            PG8_WAIT_V(6); PG8_BAR; PG8_MMA(1, 1, At, B1); PG8_BAR;
            PG8_LDB(B0, 1, 0); PG8_SCHED; PG8_LDA(At, 1, 0); PG8_STAGE(PG8_SA(0, 1), a2 + hstep, voffA);
            PG8_WAIT_L(8); PG8_BAR; PG8_WAIT_L(0); PG8_MMA(0, 0, At, B0); PG8_BAR; PG8_SCHED;
            PG8_LDB(B1, 1, 1); PG8_STAGE(PG8_SB(1, 0), b3, voffB);
            PG8_BAR; PG8_WAIT_L(0); PG8_MMA(0, 1, At, B1); PG8_BAR;
            PG8_LDA(At, 1, 1); PG8_STAGE(PG8_SA(1, 0), a3, voffA);
            PG8_BAR; PG8_WAIT_L(0); PG8_MMA(1, 0, At, B0); PG8_BAR; PG8_SCHED;
            PG8_STAGE(PG8_SB(1, 1), b3 + hstep, voffB);
            PG8_WAIT_V(6); PG8_BAR; PG8_MMA(1, 1, At, B1); PG8_BAR;
            }
        }
        if constexpr (ALIGN_EPI) { if (wr == 0) PG8_BAR; }
        if constexpr (!Epi::AFTER_DRAIN) { E(acc, cur, wr, wc, fr, fq); S.done(cur); }
        if (!has_next) break;
#pragma unroll
        for (int a = 0; a < 2; ++a)
#pragma unroll
            for (int b = 0; b < 2; ++b)
#pragma unroll
                for (int m = 0; m < 4; ++m)
#pragma unroll
                    for (int n = 0; n < 2; ++n) acc[a][b][m][n] = (f32x4){0.f, 0.f, 0.f, 0.f};
        cur = nxt; cA = nA; cB = nB; ++ui;
        if constexpr (ALIGN_EPI) { if (wr == 1) PG8_BAR; }
    }
    PG8_WAIT_V(0);
    if constexpr (!ALIGN_EPI) { if (wr == 0) PG8_BAR; }
    PG8_BAR;
    if constexpr (Epi::AFTER_DRAIN) { E.fused(acc, cur, wr, wc, fr, fq, lds, wid, lane); S.done(cur); }
#undef PG8_SA
#undef PG8_SB
#undef PG8_STAGE
#undef PG8_LDA
#undef PG8_LDB
#undef PG8_MMA
#undef PG8_WAIT_V
#undef PG8_WAIT_L
#undef PG8_BAR
#undef PG8_SCHED
}
}

#define GAS __attribute__((address_space(1)))
#define LAS __attribute__((address_space(3)))
typedef float f32x4 __attribute__((ext_vector_type(4)));
typedef unsigned u32x2 __attribute__((ext_vector_type(2)));
typedef unsigned u32x4 __attribute__((ext_vector_type(4)));
constexpr int NT = 512;
constexpr int LDS_BYTES = 147456;
constexpr int RING_BYTES = 131072, LDSCTL_OFF = RING_BYTES, MISC_OFF = LDSCTL_OFF + 320, HALO_OFF = 132096;
static_assert(HALO_OFF + 8192 <= LDS_BYTES && MISC_OFF + 128 <= HALO_OFF, "LDS map");
#define XB_TMO      128
#define XB_XCNT(j)  (256  + 64 * (j))
#define XB_XSUB(j)  (1280 + 64 * (j))
#define XB_XGEN(j)  (2304 + 64 * (j))
#define XB_TOP      3328
#define XB_TOPGEN   3392
#define XCD_BAR_WORDS 3456
#define XB_SPIN_CAP (1u << 18)

__device__ __forceinline__ unsigned xb_ld(unsigned* p)              { return __hip_atomic_load(p, __ATOMIC_RELAXED, __HIP_MEMORY_SCOPE_AGENT); }
__device__ __forceinline__ unsigned xb_add(unsigned* p, unsigned v) { return __hip_atomic_fetch_add(p, v, __ATOMIC_RELAXED, __HIP_MEMORY_SCOPE_AGENT); }
__device__ __forceinline__ unsigned xb_xcc_id() { return (unsigned)__builtin_amdgcn_s_getreg((3 << 11) | 20) & 0xFu; }
#define XB_SPIN(cond, bar) do { unsigned _sp = 0; while (cond) { __builtin_amdgcn_s_sleep(1); \
    if ((++_sp & 255u) == 0u) { if (xb_ld(&(bar)[XB_TMO])) break; if (_sp > XB_SPIN_CAP) { atomicAdd(&(bar)[XB_TMO], 1u); break; } } } } while (0)

struct XcdBarrier {
    unsigned* bar; unsigned x;
    volatile LAS unsigned* st;
};

__device__ __forceinline__ XcdBarrier xcd_barrier_post(unsigned* bar, volatile LAS unsigned* st) {
    XcdBarrier b; b.bar = bar; b.x = xb_xcc_id(); b.st = st;
    if (threadIdx.x == 0) (void)xb_add(&bar[XB_XCNT(b.x)], 1u);
    return b;
}
__device__ __forceinline__ void xcd_barrier_complete(unsigned* bar, unsigned x, unsigned& nloc, unsigned& nx) {
    const unsigned G = gridDim.x * gridDim.y * gridDim.z;
    unsigned sum, cnt, mine, sp = 0u;
    for (;;) {
        sum = 0u; cnt = 0u; mine = 0u;
#pragma unroll
        for (unsigned j = 0; j < 16; ++j) { const unsigned c = xb_ld(&bar[XB_XCNT(j)]); sum += c; cnt += (c > 0u) ? 1u : 0u; mine = (j == x) ? c : mine; }
        if (sum == G) break;
        __builtin_amdgcn_s_sleep(1);
        if ((++sp & 255u) == 0u) { if (xb_ld(&bar[XB_TMO])) break; if (sp > XB_SPIN_CAP) { atomicAdd(&bar[XB_TMO], 1u); break; } }
    }
    nloc = mine > 0u ? mine : 1u; nx = cnt > 0u ? cnt : 1u;
}

__device__ __forceinline__ void xcd_barrier(const XcdBarrier& b) {
    asm volatile("s_waitcnt vmcnt(0)" ::: "memory");
    __syncthreads();
    if (threadIdx.x == 0) {
        unsigned* bar = b.bar; const unsigned bx_ = (unsigned)__builtin_amdgcn_readfirstlane((int)xb_xcc_id());
        __builtin_amdgcn_s_waitcnt(0);
        unsigned nloc = b.st[0], nx = b.st[1];
        if (nloc == 0u) { xcd_barrier_complete(bar, bx_, nloc, nx); b.st[0] = nloc; b.st[1] = nx; }
        const unsigned old = xb_add(&bar[XB_XSUB(bx_)], 1u);
        const unsigned gen = old / nloc;
        if (old + 1u == (gen + 1u) * nloc) {
            __builtin_amdgcn_fence(__ATOMIC_RELEASE, "agent");
            asm volatile("s_waitcnt vmcnt(0)" ::: "memory");
            const unsigned og = xb_add(&bar[XB_TOP], 1u);
            const unsigned tg = og / nx;
            if (og + 1u == (tg + 1u) * nx) xb_add(&bar[XB_TOPGEN], 1u);
            else XB_SPIN(xb_ld(&bar[XB_TOPGEN]) == tg, bar);
            __builtin_amdgcn_fence(__ATOMIC_ACQUIRE, "agent");
            xb_add(&bar[XB_XGEN(bx_)], 1u);
            asm volatile("s_waitcnt vmcnt(0)" ::: "memory");
        } else {
            XB_SPIN(xb_ld(&bar[XB_XGEN(bx_)]) == gen, bar);
            __builtin_amdgcn_fence(__ATOMIC_ACQUIRE, "agent");
            asm volatile("s_waitcnt vmcnt(0)" ::: "memory");
        }
    }
    __syncthreads();
}

constexpr size_t MiB = 1u << 20;
constexpr size_t WS_CTL = 0, CTL_ZERO_BYTES = 64 * 1024, WS_MISC = 1 * MiB, WS_XC = 5 * MiB, WS_WIN = 9 * MiB, WS_WGLU = 33 * MiB, WS_WOUT = 35 * MiB, WS_WUP = 43 * MiB, WS_WDN = 87 * MiB,
                 WS_H = 109 * MiB, WS_P = 143 * MiB, WS_OFB = 245 * MiB, WS_S5Y = 279 * MiB, WS_Y = 296 * MiB, WS_S5M = 330 * MiB, WS_END = 378 * MiB;
constexpr size_t WS_ACT = WS_P;
static_assert((size_t)M * INC * 2 <= 102 * MiB && (size_t)M * D * 2 <= 34 * MiB && (size_t)M * DFF * 2 <= 102 * MiB, "ws map");
constexpr int CW_BAR = 1024;
static_assert((CW_BAR + XCD_BAR_WORDS) * 4 <= (int)CTL_ZERO_BYTES, "ctl");

struct Args { const float* in[N_IN]; float* out; unsigned char* ws; int pad0, pad1; };
struct Bufs {
    float *MOD, *LB, *AB, *BB, *XC; float* A16; bf16 *WIN, *WGLU, *WOUT, *WUP, *WDN, *H, *P, *ACT, *OF, *OB, *S5Y, *Y, *S5M;
};
__device__ __forceinline__ float* xrow_ptr(float* xc, float* xo, int r) { return r < MC ? xc + (size_t)r * D : xo + (size_t)(r - MC) * D; }
__device__ __forceinline__ float wave_sum(float v) {
#pragma unroll
    for (int o = 1; o < 64; o <<= 1) v += __shfl_xor(v, o);
    return v;
}
__device__ __forceinline__ unsigned pk2(float lo, float hi) { return (unsigned)f2bf(lo) | ((unsigned)f2bf(hi) << 16); }

#define TIDX tid_fresh()
__device__ __forceinline__ int tid_fresh() { int t = threadIdx.x; asm volatile("" : "+v"(t)); return t; }
__device__ __forceinline__ void p_mod(const Args& a, const Bufs& B, LAS unsigned char* lds, int vcu, int G) {
    LAS float* sc = (LAS float*)lds;
    LAS float* part = sc + 5 * 1024;
    const int tid = TIDX;
    for (int i = tid; i < 5 * 1024; i += NT) { const int r = i >> 10, k = i & 1023; const float c = r < 4 ? a.in[I_C][r * D + k] : a.in[I_CCTX][k]; sc[i] = siluf_(c); }
    __syncthreads();
    const int kq = tid >> 7, jc = tid & 127;
    for (int it = vcu; it < DEPTH * 48; it += G) {
        const int l = it / 48, j0 = (it % 48) * 128;
        const float* w = a.in[I_WMOD] + (size_t)l * D * 6 * D + (size_t)(kq * 256) * 6 * D + j0 + jc;
        float acc[5] = {0.f, 0.f, 0.f, 0.f, 0.f};
#pragma unroll 8
        for (int k = 0; k < 256; ++k) { const float wv = w[(size_t)k * 6 * D];
#pragma unroll
            for (int r = 0; r < 5; ++r) acc[r] += sc[r * 1024 + kq * 256 + k] * wv; }
#pragma unroll
        for (int r = 0; r < 5; ++r) part[(kq * 5 + r) * 128 + jc] = acc[r];
        __syncthreads();
        if (kq == 0) {
#pragma unroll
            for (int r = 0; r < 5; ++r) B.MOD[((size_t)l * 5 + r) * 6 * D + j0 + jc] = a.in[I_BMOD][l * 6 * D + j0 + jc] + part[r * 128 + jc] + part[(5 + r) * 128 + jc] + part[(10 + r) * 128 + jc] + part[(15 + r) * 128 + jc];
        }
        __syncthreads();
    }
}
__device__ __forceinline__ void p_small(const Args& a, const Bufs& B, int vcu, int G) {
    const int gt = vcu * NT + TIDX, NGT = G * NT;
    for (int idx = gt; idx < 2 * HGW; idx += NGT) {
        float v[DEPTH], mx = -1e30f;
#pragma unroll
        for (int l = 0; l < DEPTH; ++l) { v[l] = a.in[I_HGLB][l * 2 * HGW + idx]; mx = fmaxf(mx, v[l]); }
        float s = 0.f;
#pragma unroll
        for (int l = 0; l < DEPTH; ++l) { v[l] = __expf(v[l] - mx); s += v[l]; }
        float cum = 0.f, first = 0.f;
#pragma unroll
        for (int l = 0; l < DEPTH; ++l) { cum += v[l] / s; if (l == 0) first = cum; B.LB[l * 2 * HGW + idx] = cum - first; }
    }
    for (int idx = gt; idx < DEPTH * 2 * S5G * S5P; idx += NGT) {
        const int ldg = idx / S5P;
        const float lr = a.in[I_LRE][idx], li = a.in[I_LIM][idx], dt = expf(a.in[I_LDT][ldg]);
        const float mag = expf(lr * dt), ang = li * dt;
        const float ar = mag * cosf(ang), ai = mag * sinf(ang);
        B.AB[idx * 2] = ar; B.AB[idx * 2 + 1] = ai;
        const float den = lr * lr + li * li, nr = ar - 1.f, ni = ai;
        const float cr = (nr * lr + ni * li) / den, ci = (ni * lr - nr * li) / den;
        for (int h = 0; h < S5H; ++h) {
            const float br = a.in[I_BRE][(size_t)idx * S5H + h], bi = a.in[I_BIM][(size_t)idx * S5H + h];
            B.BB[((size_t)idx * S5H + h) * 2] = cr * br - ci * bi; B.BB[((size_t)idx * S5H + h) * 2 + 1] = cr * bi + ci * br;
        }
    }
    { const f32x4* s = (const f32x4*)a.in[I_X]; f32x4* d = (f32x4*)a.out; for (size_t i = gt; i < (size_t)MX * D / 4; i += NGT) d[i] = s[i]; }
    { const f32x4* s = (const f32x4*)a.in[I_CTX]; f32x4* d = (f32x4*)B.XC; for (size_t i = gt; i < (size_t)MC * D / 4; i += NGT) d[i] = s[i]; }
}
__device__ __forceinline__ void wprep_tile(const float* W, bf16* Wt, int K, int N, int mode, int tn, int tk, LAS float* tile, int t256) {
    const int n0 = tn * 64, k0 = tk * 64, tx = t256 & 63, ty = t256 >> 6;
    const int np = n0 + tx; const int nsrc = mode == 1 ? (((np & 255) < 128 ? 0 : DFF) + 128 * (np >> 8) + (np & 127)) : np;
    for (int i = ty; i < 64; i += 4) tile[i * 65 + tx] = W[(size_t)(k0 + i) * N + nsrc];
    __syncthreads();
    for (int i = ty; i < 64; i += 4) Wt[(size_t)(n0 + i) * K + k0 + tx] = f2bf(tile[tx * 65 + i]);
    __syncthreads();
}
__device__ __forceinline__ void p_wprep(const Args& a, const Bufs& B, LAS unsigned char* lds, int vcu, int G) {
    constexpr int T_IN = 768, T_GLU = 64, T_OUT = 256, T_UP = 1408, T_DN = 704, T_L = T_IN + T_GLU + T_OUT + T_UP + T_DN;
    const int half = TIDX >> 8, t256 = TIDX & 255;
    LAS float* tile = (LAS float*)lds + half * (64 * 65);
    for (int it = vcu; it < DEPTH * T_L / 2; it += G) {
        const int item = it * 2 + half; const int l = item / T_L; int r = item % T_L;
        if (r < T_IN) { wprep_tile(a.in[I_WIN] + (size_t)l * D * INC, B.WIN + (size_t)l * INC * D, D, INC, 0, r % 48, r / 48, tile, t256); continue; } r -= T_IN;
        if (r < T_GLU) { wprep_tile(a.in[I_WGLU] + (size_t)l * S5W * S5W, B.WGLU + (size_t)l * S5W * S5W, S5W, S5W, 0, r % 8, r / 8, tile, t256); continue; } r -= T_GLU;
        if (r < T_OUT) { wprep_tile(a.in[I_WOUT] + (size_t)l * D * D, B.WOUT + (size_t)l * D * D, D, D, 0, r % 16, r / 16, tile, t256); continue; } r -= T_OUT;
        if (r < T_UP) { wprep_tile(a.in[I_WUP] + (size_t)l * D * 2 * DFF, B.WUP + (size_t)l * 2 * DFF * D, D, 2 * DFF, 1, r % 88, r / 88, tile, t256); continue; } r -= T_UP;
        wprep_tile(a.in[I_WDOWN] + (size_t)l * DFF * D, B.WDN + (size_t)l * D * DFF, DFF, D, 0, r % 16, r / 16, tile, t256);
    }
}
__device__ __forceinline__ void p_modulate(const Args& a, const Bufs& B, const float* modl, int off_sh, int off_sc, int vcu, int G) {
    const int lane = TIDX & 63, gw = vcu * 8 + (TIDX >> 6), NGW = G * 8;
    for (int r = gw; r < M; r += NGW) {
        const f32x4* x = (const f32x4*)xrow_ptr(B.XC, a.out, r) + lane; const float* mr = modl + (size_t)row_modidx(r) * 6 * D;
        u32x2* o = (u32x2*)(B.H + (size_t)r * D) + lane;
#pragma unroll
        for (int j = 0; j < 4; ++j) { const f32x4 v = x[64 * j], sc = *((const f32x4*)(mr + off_sc) + lane + 64 * j), sh = *((const f32x4*)(mr + off_sh) + lane + 64 * j);
            u32x2 w; w.x = pk2(v[0] * (1.f + sc[0]) + sh[0], v[1] * (1.f + sc[1]) + sh[1]); w.y = pk2(v[2] * (1.f + sc[2]) + sh[2], v[3] * (1.f + sc[3]) + sh[3]); o[64 * j] = w; }
    }
}
__device__ __forceinline__ void p_ln(float* XCp, float* XOp, bf16* Hp, const float* lg, const float* lbv, const float* modn, int off_sh, int off_sc, int vcu, int G) {
    const int lane = TIDX & 63, gw = vcu * 8 + (TIDX >> 6), NGW = G * 8;
    for (int r = gw; r < M; r += NGW) {
        f32x4* x = (f32x4*)xrow_ptr(XCp, XOp, r) + lane;
        f32x4 v[4]; float s = 0.f;
#pragma unroll
        for (int j = 0; j < 4; ++j) { v[j] = x[64 * j]; s += (v[j][0] + v[j][1]) + (v[j][2] + v[j][3]); }
        const float mean = wave_sum(s) * (1.f / D); float q = 0.f;
#pragma unroll
        for (int j = 0; j < 4; ++j) { v[j] = v[j] - mean; q += (v[j][0] * v[j][0] + v[j][1] * v[j][1]) + (v[j][2] * v[j][2] + v[j][3] * v[j][3]); }
        const float rstd = rsqrtf(wave_sum(q) * (1.f / D) + LN_EPS);
        const float* mr = modn ? modn + (size_t)row_modidx(r) * 6 * D : nullptr;
        u32x2* o = (u32x2*)(Hp + (size_t)r * D) + lane;
#pragma unroll
        for (int j = 0; j < 4; ++j) { const f32x4 g = *((const f32x4*)lg + lane + 64 * j), bb = *((const f32x4*)lbv + lane + 64 * j); const f32x4 y = v[j] * rstd * g + bb; x[64 * j] = y;
            if (mr) { const f32x4 sc = *((const f32x4*)(mr + off_sc) + lane + 64 * j), sh = *((const f32x4*)(mr + off_sh) + lane + 64 * j);
                u32x2 w; w.x = pk2(y[0] * (1.f + sc[0]) + sh[0], y[1] * (1.f + sc[1]) + sh[1]); w.y = pk2(y[2] * (1.f + sc[2]) + sh[2], y[3] * (1.f + sc[3]) + sh[3]); o[64 * j] = w; } }
    }
}

__device__ __forceinline__ int s5_row(int b, int d, int s) {
    if (s < CTX) { const int t = d ? CTX - 1 - s : s; return b * CTX + t; }
    const int t = d ? SEQ - 1 - (s - CTX) : (s - CTX); return MC + b * SEQ + t;
}
__device__ __forceinline__ void p_mixout(const Args& a, const Bufs& B, int l, int first, int stride) {
    const float* nw = a.in[I_HGNW] + (size_t)l * HD;
    const int lane = TIDX & 63, c0 = 8 * lane;
    const f32x4 nw0 = *(const f32x4*)(nw + (c0 & 127)), nw1 = *(const f32x4*)(nw + (c0 & 127) + 4);
    for (int r = first; r < M; r += stride) {
        const u32x4 of = *(const u32x4*)(B.OF + (size_t)r * HGW + c0), ob = *(const u32x4*)(B.OB + (size_t)r * HGW + c0), gg = *(const u32x4*)(B.P + (size_t)r * INC + 2560 + c0);
        float o[8], g[8];
        o[0] = pg8::bflo(of.x) + pg8::bflo(ob.x); o[1] = pg8::bfhi(of.x) + pg8::bfhi(ob.x); o[2] = pg8::bflo(of.y) + pg8::bflo(ob.y); o[3] = pg8::bfhi(of.y) + pg8::bfhi(ob.y);
        o[4] = pg8::bflo(of.z) + pg8::bflo(ob.z); o[5] = pg8::bfhi(of.z) + pg8::bfhi(ob.z); o[6] = pg8::bflo(of.w) + pg8::bflo(ob.w); o[7] = pg8::bfhi(of.w) + pg8::bfhi(ob.w);
        g[0] = pg8::bflo(gg.x); g[1] = pg8::bfhi(gg.x); g[2] = pg8::bflo(gg.y); g[3] = pg8::bfhi(gg.y); g[4] = pg8::bflo(gg.z); g[5] = pg8::bfhi(gg.z); g[6] = pg8::bflo(gg.w); g[7] = pg8::bfhi(gg.w);
        float s = 0.f;
#pragma unroll
        for (int j = 0; j < 8; ++j) s += o[j] * o[j];
        s += __shfl_xor(s, 1); s += __shfl_xor(s, 2); s += __shfl_xor(s, 4); s += __shfl_xor(s, 8);
        const float rs = rsqrtf(s * (1.f / 128.f) + RMS_EPS);
        float y[8];
#pragma unroll
        for (int j = 0; j < 8; ++j) y[j] = o[j] * rs * (j < 4 ? nw0[j] : nw1[j - 4]) * siluf_(g[j]);
        *(u32x4*)(B.Y + (size_t)r * D + 512 + c0) = (u32x4){pk2(y[0], y[1]), pk2(y[2], y[3]), pk2(y[4], y[5]), pk2(y[6], y[7])};
    }
}

constexpr size_t S5M_W1 = 256 * 256, S5M_W3 = 256 * 512, S5M_PER = S5M_W1 + S5M_W3;
__device__ __forceinline__ void p_s5mats(const Args& a, bf16* S5M, float* A16, LAS unsigned char* lds, int vcu, int G) {
    LAS float* pw = (LAS float*)lds;
    LAS float* bb = pw + 2 * 17 * 64 * 2;
    LAS float* cc = bb + 2 * 64 * 16 * 2;
    LAS float* Kn = cc + 2 * 16 * 64 * 2;
    const int tid = TIDX;
    for (int it = vcu; it < DEPTH * S5G; it += G) {
        const int l = it / S5G, g = it % S5G;
        for (int i = tid; i < 2 * 17 * 64; i += NT) { const int p = i & 63, n = (i >> 6) % 17, d = i / (17 * 64);
            const int li_ = ((l * 2 + d) * S5G + g) * S5P + p; const float lr = a.in[I_LRE][li_], li = a.in[I_LIM][li_], dt = expf(a.in[I_LDT][(l * 2 + d) * S5G + g]);
            const float mag = expf((float)n * lr * dt), ang = (float)n * li * dt; pw[i * 2] = mag * cosf(ang); pw[i * 2 + 1] = mag * sinf(ang); }
        for (int i = tid; i < 2 * 64 * 16; i += NT) { const int h = i & 15, p = (i >> 4) & 63, d = i >> 10;
            const int li_ = ((l * 2 + d) * S5G + g) * S5P + p; const float lr = a.in[I_LRE][li_], li = a.in[I_LIM][li_], dt = expf(a.in[I_LDT][(l * 2 + d) * S5G + g]);
            const float mag = expf(lr * dt), ang = li * dt; const float ar = mag * cosf(ang), ai = mag * sinf(ang);
            const float den = lr * lr + li * li, nr = ar - 1.f, ni = ai; const float cr = (nr * lr + ni * li) / den, ci = (ni * lr - nr * li) / den;
            const float br = a.in[I_BRE][(size_t)li_ * S5H + h], bi = a.in[I_BIM][(size_t)li_ * S5H + h];
            bb[i * 2] = cr * br - ci * bi; bb[i * 2 + 1] = cr * bi + ci * br; }
        for (int i = tid; i < 2 * 16 * 64; i += NT) { const int p = i & 63, h = (i >> 6) & 15, d = i >> 10; const size_t ci_ = ((size_t)((l * 2 + d) * S5G + g) * S5H + h) * S5P + p;
            cc[i * 2] = a.in[I_CRE][ci_]; cc[i * 2 + 1] = a.in[I_CIM][ci_]; }
        __syncthreads();
        for (int i = tid; i < 2 * 16 * 16 * 16; i += NT) { const int h = i & 15, hp = (i >> 4) & 15, n = (i >> 8) & 15, d = i >> 12; float s = 0.f;
            for (int p = 0; p < 64; ++p) { const float cr = cc[((d * 16 + hp) * 64 + p) * 2], ci = cc[((d * 16 + hp) * 64 + p) * 2 + 1], ar = pw[((d * 17 + n) * 64 + p) * 2], ai = pw[((d * 17 + n) * 64 + p) * 2 + 1];
                const float tr = cr * ar - ci * ai, ti = cr * ai + ci * ar; s += tr * bb[((d * 64 + p) * 16 + h) * 2] - ti * bb[((d * 64 + p) * 16 + h) * 2 + 1]; }
            Kn[i] = s; }
        __syncthreads();
        bf16* W1 = S5M + (size_t)it * S5M_PER; bf16* W3 = W1 + S5M_W1;
        for (int c = tid; c < 256 * 32; c += NT) {
            const int n = c >> 5, k0 = (c & 31) * 8, d = n >> 7, ri = (n >> 6) & 1, p = n & 63, i = k0 >> 4, h0 = k0 & 15, e = d == 0 ? 15 - i : i;
            const float ar = pw[((d * 17 + e) * 64 + p) * 2], ai = pw[((d * 17 + e) * 64 + p) * 2 + 1]; unsigned w[4];
#pragma unroll
            for (int q = 0; q < 4; ++q) { float v[2];
#pragma unroll
                for (int t = 0; t < 2; ++t) { const int h = h0 + 2 * q + t; const float br = bb[((d * 64 + p) * 16 + h) * 2], bi = bb[((d * 64 + p) * 16 + h) * 2 + 1]; v[t] = ri == 0 ? ar * br - ai * bi : ar * bi + ai * br; }
                w[q] = pk2(v[0], v[1]); }
            *(u32x4*)(W1 + (size_t)n * 256 + k0) = (u32x4){w[0], w[1], w[2], w[3]};
        }
        const float* dsk = a.in[I_SD] + (size_t)l * S5W + g * 16;
        for (int c = tid; c < 256 * 64; c += NT) {
            const int n = c >> 6, k0 = (c & 63) * 8, j = n >> 4, hp = n & 15; float v[8];
            if (k0 < 256) { const int i = k0 >> 4, h0 = k0 & 15;
#pragma unroll
                for (int t = 0; t < 8; ++t) { const int h = h0 + t; float s = 0.f;
                    if (i <= j) s += Kn[((0 * 16 + (j - i)) * 16 + hp) * 16 + h];
                    if (i >= j) s += Kn[((1 * 16 + (i - j)) * 16 + hp) * 16 + h];
                    if (i == j && h == hp) s += dsk[h];
                    v[t] = s; }
            } else { const int kk = k0 - 256, d = kk >> 7, ri = (kk >> 6) & 1, p0 = kk & 63, e = d == 0 ? j + 1 : 16 - j;
#pragma unroll
                for (int t = 0; t < 8; ++t) { const int p = p0 + t; const float cr = cc[((d * 16 + hp) * 64 + p) * 2], ci = cc[((d * 16 + hp) * 64 + p) * 2 + 1], ar = pw[((d * 17 + e) * 64 + p) * 2], ai = pw[((d * 17 + e) * 64 + p) * 2 + 1];
                    v[t] = ri == 0 ? cr * ar - ci * ai : -(cr * ai + ci * ar); } }
            *(u32x4*)(W3 + (size_t)n * 512 + k0) = (u32x4){pk2(v[0], v[1]), pk2(v[2], v[3]), pk2(v[4], v[5]), pk2(v[6], v[7])};
        }
        for (int i = tid; i < 2 * 64; i += NT) { const int p = i & 63, d = i >> 6; A16[((size_t)it * 2 + d) * 128 + p * 2] = pw[((d * 17 + 16) * 64 + p) * 2]; A16[((size_t)it * 2 + d) * 128 + p * 2 + 1] = pw[((d * 17 + 16) * 64 + p) * 2 + 1]; }
        __syncthreads();
    }
}
typedef short bf16x8_t __attribute__((ext_vector_type(8)));
__device__ __forceinline__ void p_s5(const Args& a, const Bufs& B, const bf16* S5M, const float* A16, int l, LAS unsigned char* lds, int vcu, int G) {
    constexpr int XROW = 136;
    LAS bf16* XB = (LAS bf16*)lds;
    LAS bf16* XF = XB + 272 * XROW;
    LAS float* DX = (LAS float*)(lds + (272 + 32) * XROW * 2);
    const int tid = TIDX, lane = tid & 63, w = __builtin_amdgcn_readfirstlane(tid >> 6), l15 = lane & 15, lq = lane >> 4;
    for (int task = vcu; task < BATCH * S5G; task += G) {
        const int b = task / S5G, g = task % S5G;
        const bf16* W1 = S5M + (size_t)(l * S5G + g) * S5M_PER; const bf16* W3 = W1 + S5M_W1;
        const float* a16 = A16 + (size_t)(l * S5G + g) * 256;
        const bf16* Pu = B.P + g * 16 + 8 * (lq & 1);
#pragma unroll 1
        for (int sweep = 0; sweep < 2; ++sweep) {
            const int d = sweep == 0 ? 1 : 0;
            bf16x8_t bw[8];
#pragma unroll
            for (int ks = 0; ks < 8; ++ks) bw[ks] = *(const bf16x8_t*)(W1 + (size_t)(d * 128 + 16 * w + l15) * 256 + 32 * ks + 8 * lq);
            float xr = 0.f, xi = 0.f; const float ar = a16[d * 128 + (lane) * 2], ai = a16[d * 128 + (lane) * 2 + 1];
#pragma unroll 1
            for (int ti = 0; ti < 9; ++ti) {
                const int tile = d == 0 ? ti : (ti == 0 ? 0 : 9 - ti);
                const int c0 = tile == 0 ? 0 : 16 + 32 * (tile - 1), nch = tile == 0 ? 16 : 32;
                for (int mt = 0; mt < nch / 16; ++mt) {
                    const int ch = c0 + 16 * mt + l15; const int rb = ch < 16 ? b * CTX + 16 * ch : MC + b * SEQ + 16 * (ch - 16);
                    const bf16* up = Pu + (size_t)(rb + (lq >> 1)) * INC;
                    f32x4 acc = (f32x4){0.f, 0.f, 0.f, 0.f};
#pragma unroll
                    for (int ks = 0; ks < 8; ++ks) { const bf16x8_t av = *(const bf16x8_t*)(up + (size_t)(2 * ks) * INC); acc = __builtin_amdgcn_mfma_f32_16x16x32_bf16(av, bw[ks], acc, 0, 0, 0); }
#pragma unroll
                    for (int r = 0; r < 4; ++r) DX[(16 * mt + 4 * lq + r) * 132 + 16 * w + l15] = acc[r];
                }
                __syncthreads();
                if (w == 0) {
                    if (d == 0) { for (int cl = 0; cl < nch; ++cl) { XF[cl * XROW + lane] = f2bf(xr); XF[cl * XROW + 64 + lane] = f2bf(xi);
                            const float dr = DX[cl * 132 + lane], di = DX[cl * 132 + 64 + lane]; const float nr = ar * xr - ai * xi + dr, ni = ar * xi + ai * xr + di; xr = nr; xi = ni; } }
                    else { for (int cl = nch - 1; cl >= 0; --cl) { XB[(c0 + cl) * XROW + lane] = f2bf(xr); XB[(c0 + cl) * XROW + 64 + lane] = f2bf(xi);
                            const float dr = DX[cl * 132 + lane], di = DX[cl * 132 + 64 + lane]; const float nr = ar * xr - ai * xi + dr, ni = ar * xi + ai * xr + di; xr = nr; xi = ni; } }
                }
                __syncthreads();
                if (d == 0) {
                    f32x4 y[2][2];
#pragma unroll
                    for (int mt = 0; mt < 2; ++mt)
#pragma unroll
                        for (int nt = 0; nt < 2; ++nt) y[mt][nt] = (f32x4){0.f, 0.f, 0.f, 0.f};
                    const int nmt = nch / 16;
#pragma unroll 4
                    for (int ks = 0; ks < 16; ++ks) {
                        bf16x8_t bv[2];
#pragma unroll
                        for (int nt = 0; nt < 2; ++nt) bv[nt] = *(const bf16x8_t*)(W3 + (size_t)(32 * w + 16 * nt + l15) * 512 + 32 * ks + 8 * lq);
#pragma unroll
                        for (int mt = 0; mt < 2; ++mt) { if (mt < nmt) {
                            bf16x8_t av;
                            if (ks < 8) { const int ch = c0 + 16 * mt + l15; const int rb = ch < 16 ? b * CTX + 16 * ch : MC + b * SEQ + 16 * (ch - 16); av = *(const bf16x8_t*)(Pu + (size_t)(rb + (lq >> 1) + 2 * ks) * INC); }
                            else if (ks < 12) av = *(const LAS bf16x8_t*)(XF + (16 * mt + l15) * XROW + 32 * (ks - 8) + 8 * lq);
                            else av = *(const LAS bf16x8_t*)(XB + (c0 + 16 * mt + l15) * XROW + 32 * (ks - 12) + 8 * lq);
#pragma unroll
                            for (int nt = 0; nt < 2; ++nt) y[mt][nt] = __builtin_amdgcn_mfma_f32_16x16x32_bf16(av, bv[nt], y[mt][nt], 0, 0, 0); } }
                    }
#pragma unroll
                    for (int mt = 0; mt < 2; ++mt) { if (mt < nmt) {
#pragma unroll
                        for (int nt = 0; nt < 2; ++nt)
#pragma unroll
                            for (int r = 0; r < 4; ++r) { const int ch = c0 + 16 * mt + 4 * lq + r; const int rb = ch < 16 ? b * CTX + 16 * ch : MC + b * SEQ + 16 * (ch - 16);
                                B.S5Y[(size_t)(rb + 2 * w + nt) * S5W + g * 16 + l15] = f2bf(gelu_tanh(y[mt][nt][r])); } } }
                }
            }
        }
        __syncthreads();
    }
}

constexpr int GL_ST = 0, GL_QT = 34816, GL_QA = 43520, GL_KA = 52224, GL_KDT = 60928, GL_VT = 71168, GL_ATT = 81408, GL_DEC = 83968, GL_PART = 84480;
constexpr size_t GLS_S = 128 * 128, GLS_PER = GLS_S + 128;
__device__ __forceinline__ int gla_rowbase(int b, int d, int q) {
    if (q < 8) { const int qq = d ? 7 - q : q; return b * CTX + 32 * qq; }
    const int qq = d ? 127 - (q - 8) : (q - 8); return MC + b * SEQ + 32 * qq;
}
__device__ __forceinline__ float fexp(float x) { return __expf(x); }
struct GlaRegs { unsigned short f[8], v[8], q[8]; };
template <bool FULL> __device__ __forceinline__ void gla_load(GlaRegs& R, const bf16* P, int rowbase, int hd, int d, int tid) {
    const int k = tid & 127, tg = tid >> 7;
    const bf16* pr = P + (size_t)(rowbase + 8 * tg) * INC + hd * HD + k;
#pragma unroll
    for (int i = 0; i < 8; ++i) { R.f[i] = pr[(size_t)i * INC + 512 + d * 512]; R.v[i] = pr[(size_t)i * INC + 1536]; if (FULL) R.q[i] = pr[(size_t)i * INC + 2048]; }
}
template <bool FULL> __device__ __forceinline__ void gla_build(const GlaRegs& R, int d, float lbk, LAS unsigned char* lds, int tid, float& sumbend) {
    const int k = tid & 127, tg = tid >> 7;
    LAS float* PART = (LAS float*)(lds + GL_PART); LAS float* DEC = (LAS float*)(lds + GL_DEC);
    float lf[8], kk[8], vv[8], qq[8];
    float s = 0.f;
#pragma unroll
    for (int i = 0; i < 8; ++i) { const float raw = bf2f(R.f[i]); const float f = lbk + (1.f - lbk) * sigmoidf_(raw);
        lf[i] = fmaxf(__logf(f), -30.f); kk[i] = 1.f - f; s += lf[i]; vv[i] = bf2f(R.v[i]); if (FULL) qq[i] = siluf_(bf2f(R.q[i])); }
    PART[tg * 128 + k] = s;
    __syncthreads();
    const float p0 = PART[k], p1 = PART[128 + k], p2 = PART[256 + k], p3 = PART[384 + k];
    const float total = (p0 + p1) + (p2 + p3);
    float base, r;
    if (d == 0) { base = tg == 0 ? 0.f : (tg == 1 ? p0 : (tg == 2 ? p0 + p1 : p0 + p1 + p2)); r = p0 + p1; }
    else        { base = tg == 3 ? 0.f : (tg == 2 ? p3 : (tg == 1 ? p3 + p2 : p3 + p2 + p1)); r = p2 + p3; }
    float bc[8];
    if (d == 0) { float run = base;
#pragma unroll
        for (int i = 0; i < 8; ++i) { run += lf[i]; bc[i] = run; } }
    else { float run = base;
#pragma unroll
        for (int i = 7; i >= 0; --i) { run += lf[i]; bc[i] = run; } }
    { unsigned w[4];
#pragma unroll
      for (int q2 = 0; q2 < 4; ++q2) w[q2] = pk2(kk[2 * q2] * fexp(total - bc[2 * q2]), kk[2 * q2 + 1] * fexp(total - bc[2 * q2 + 1]));
      *(LAS u32x4*)(lds + GL_KDT + (k * 40 + 8 * tg) * 2) = (u32x4){w[0], w[1], w[2], w[3]};
#pragma unroll
      for (int q2 = 0; q2 < 4; ++q2) w[q2] = pk2(vv[2 * q2], vv[2 * q2 + 1]);
      *(LAS u32x4*)(lds + GL_VT + (k * 40 + 8 * tg) * 2) = (u32x4){w[0], w[1], w[2], w[3]}; }
    if (FULL) {
        LAS bf16* QT = (LAS bf16*)(lds + GL_QT); LAS bf16* QA = (LAS bf16*)(lds + GL_QA); LAS bf16* KA = (LAS bf16*)(lds + GL_KA);
#pragma unroll
        for (int i = 0; i < 8; ++i) { const int t = 8 * tg + i;
            QT[t * 136 + k] = f2bf(qq[i] * fexp(bc[i])); QA[t * 136 + k] = f2bf(qq[i] * fexp(fminf(bc[i] - r, 80.f))); KA[t * 136 + k] = f2bf(kk[i] * fexp(fminf(r - bc[i], 80.f))); }
    }
    if (tg == 0) { DEC[k] = fexp(total); sumbend += total; }
}
__device__ __forceinline__ void gla_update(f32x4 (&S)[8], LAS unsigned char* lds, int w, int l15, int lq, bool write_st) {
    const bf16x8_t bv = *(const LAS bf16x8_t*)(lds + GL_VT + ((16 * w + l15) * 40 + 8 * lq) * 2);
#pragma unroll
    for (int kt = 0; kt < 8; ++kt) {
        const bf16x8_t av = *(const LAS bf16x8_t*)(lds + GL_KDT + ((16 * kt + l15) * 40 + 8 * lq) * 2);
        const f32x4 dec = *(const LAS f32x4*)(lds + GL_DEC + (16 * kt + 4 * lq) * 4);
        S[kt] = __builtin_amdgcn_mfma_f32_16x16x32_bf16(av, bv, S[kt] * dec, 0, 0, 0);
        if (write_st) *(LAS u32x2*)(lds + GL_ST + ((16 * w + l15) * 136 + 16 * kt + 4 * lq) * 2) = (u32x2){pk2(S[kt][0], S[kt][1]), pk2(S[kt][2], S[kt][3])};
    }
}
__device__ __forceinline__ void p_gla_sum(const Args& a, const Bufs& B, float* GLS, int l, LAS unsigned char* lds, int first, int stride) {
    const int tid = TIDX, lane = tid & 63, w = __builtin_amdgcn_readfirstlane(tid >> 6), l15 = lane & 15, lq = lane >> 4;
    for (int task = first; task < 32 * 7; task += stride) {
        const int chain = task / 7, seg = task % 7, b = chain >> 3, hd = (chain >> 1) & 3, d = chain & 1;
        const float lbk = B.LB[(size_t)l * 2 * HGW + d * HGW + hd * HD + (tid & 127)];
        f32x4 S[8];
#pragma unroll
        for (int kt = 0; kt < 8; ++kt) S[kt] = (f32x4){0.f, 0.f, 0.f, 0.f};
        float sumbend = 0.f;
        GlaRegs R; gla_load<false>(R, B.P, gla_rowbase(b, d, seg * 17), hd, d, tid);
#pragma unroll 1
        for (int c = 0; c < 17; ++c) {
            gla_build<false>(R, d, lbk, lds, tid, sumbend);
            if (c + 1 < 17) gla_load<false>(R, B.P, gla_rowbase(b, d, seg * 17 + c + 1), hd, d, tid);
            __syncthreads();
            gla_update(S, lds, w, l15, lq, false);
            __syncthreads();
        }
        float* dst = GLS + (size_t)task * GLS_PER;
#pragma unroll
        for (int kt = 0; kt < 8; ++kt) *(f32x4*)(dst + ((size_t)(kt * 8 + w) * 64 + lane) * 4) = S[kt];
        if (tid < 128) dst[GLS_S + tid] = fexp(sumbend);
    }
}
__device__ __forceinline__ void p_gla_out(const Args& a, const Bufs& B, const float* GLS, int l, LAS unsigned char* lds, int first, int stride) {
    const int tid = TIDX, lane = tid & 63, w = __builtin_amdgcn_readfirstlane(tid >> 6), l15 = lane & 15, lq = lane >> 4;
    for (int task = first; task < 32 * 8; task += stride) {
        const int chain = task >> 3, seg = task & 7, b = chain >> 3, hd = (chain >> 1) & 3, d = chain & 1;
        const float lbk = B.LB[(size_t)l * 2 * HGW + d * HGW + hd * HD + (tid & 127)];
        bf16* O = d ? B.OB : B.OF;
        f32x4 S[8];
#pragma unroll
        for (int kt = 0; kt < 8; ++kt) S[kt] = (f32x4){0.f, 0.f, 0.f, 0.f};
        for (int sp = 0; sp < seg; ++sp) {
            const float* src = GLS + (size_t)(chain * 7 + sp) * GLS_PER;
#pragma unroll
            for (int kt = 0; kt < 8; ++kt) { const f32x4 dv = *(const f32x4*)(src + GLS_S + 16 * kt + 4 * lq); S[kt] = S[kt] * dv + *(const f32x4*)(src + ((size_t)(kt * 8 + w) * 64 + lane) * 4); }
        }
#pragma unroll
        for (int kt = 0; kt < 8; ++kt) *(LAS u32x2*)(lds + GL_ST + ((16 * w + l15) * 136 + 16 * kt + 4 * lq) * 2) = (u32x2){pk2(S[kt][0], S[kt][1]), pk2(S[kt][2], S[kt][3])};
        float sumbend = 0.f;
        GlaRegs R; gla_load<true>(R, B.P, gla_rowbase(b, d, seg * 17), hd, d, tid);
#pragma unroll 1
        for (int c = 0; c < 17; ++c) {
            const int rowbase = gla_rowbase(b, d, seg * 17 + c);
            gla_build<true>(R, d, lbk, lds, tid, sumbend);
            if (c + 1 < 17) gla_load<true>(R, B.P, gla_rowbase(b, d, seg * 17 + c + 1), hd, d, tid);
            __syncthreads();
            if (w < 4) {
                const int mt = w >> 1, nt = w & 1; f32x4 acc = (f32x4){0.f, 0.f, 0.f, 0.f};
#pragma unroll
                for (int ks = 0; ks < 4; ++ks) { const bf16x8_t av = *(const LAS bf16x8_t*)(lds + GL_QA + ((16 * mt + l15) * 136 + 32 * ks + 8 * lq) * 2);
                    const bf16x8_t bv = *(const LAS bf16x8_t*)(lds + GL_KA + ((16 * nt + l15) * 136 + 32 * ks + 8 * lq) * 2); acc = __builtin_amdgcn_mfma_f32_16x16x32_bf16(av, bv, acc, 0, 0, 0); }
                LAS bf16* ATT = (LAS bf16*)(lds + GL_ATT);
#pragma unroll
                for (int r = 0; r < 4; ++r) { const int i = 16 * mt + 4 * lq + r, j = 16 * nt + l15; const bool ok = d ? (j >= i) : (j <= i); ATT[i * 40 + j] = f2bf(ok ? acc[r] : 0.f); }
            }
            __syncthreads();
            {
                f32x4 o[2] = {(f32x4){0.f, 0.f, 0.f, 0.f}, (f32x4){0.f, 0.f, 0.f, 0.f}};
#pragma unroll
                for (int ks = 0; ks < 4; ++ks) { const bf16x8_t bv = *(const LAS bf16x8_t*)(lds + GL_ST + ((16 * w + l15) * 136 + 32 * ks + 8 * lq) * 2);
#pragma unroll
                    for (int mt = 0; mt < 2; ++mt) { const bf16x8_t av = *(const LAS bf16x8_t*)(lds + GL_QT + ((16 * mt + l15) * 136 + 32 * ks + 8 * lq) * 2); o[mt] = __builtin_amdgcn_mfma_f32_16x16x32_bf16(av, bv, o[mt], 0, 0, 0); } }
                const bf16x8_t vb = *(const LAS bf16x8_t*)(lds + GL_VT + ((16 * w + l15) * 40 + 8 * lq) * 2);
#pragma unroll
                for (int mt = 0; mt < 2; ++mt) { const bf16x8_t av = *(const LAS bf16x8_t*)(lds + GL_ATT + ((16 * mt + l15) * 40 + 8 * lq) * 2); o[mt] = __builtin_amdgcn_mfma_f32_16x16x32_bf16(av, vb, o[mt], 0, 0, 0); }
#pragma unroll
                for (int mt = 0; mt < 2; ++mt)
#pragma unroll
                    for (int r = 0; r < 4; ++r) O[(size_t)(rowbase + 16 * mt + 4 * lq + r) * HGW + hd * HD + 16 * w + l15] = f2bf(o[mt][r]);
            }
            gla_update(S, lds, w, l15, lq, true);
            __syncthreads();
        }
    }
}

#ifndef REPS
#define REPS 1,1,1,1,1,1,1,1,1,1
#endif
constexpr int REPV[10] = {REPS};
constexpr int REP_A = REPV[0], REP_B = REPV[1], REP_C = REPV[2], REP_D = REPV[3], REP_E = REPV[4], REP_F = REPV[5], REP_G = REPV[6], REP_H = REPV[7], REP_I = REPV[8], REP_J = REPV[9];
__global__ void __launch_bounds__(NT, 2) mk_fwd(Args args) {
    extern __shared__ __attribute__((aligned(16))) unsigned char lds_raw[];
    LAS unsigned char* lds = (LAS unsigned char*)lds_raw;
    volatile LAS unsigned* MISC = (volatile LAS unsigned*)(lds + MISC_OFF);
    const int G = gridDim.x; const int bx = blockIdx.x; const int vcu = (G % 8 == 0) ? (bx % 8) * (G / 8) + bx / 8 : bx;
    unsigned char* ws = args.ws;
    Bufs B;
    B.MOD = (float*)(ws + WS_MISC); B.LB = B.MOD + DEPTH * 5 * 6 * D; B.AB = B.LB + DEPTH * 2 * HGW; B.BB = B.AB + DEPTH * 2 * S5G * S5P * 2;
    B.XC = (float*)(ws + WS_XC);
    B.WIN = (bf16*)(ws + WS_WIN); B.WGLU = (bf16*)(ws + WS_WGLU); B.WOUT = (bf16*)(ws + WS_WOUT); B.WUP = (bf16*)(ws + WS_WUP); B.WDN = (bf16*)(ws + WS_WDN);
    B.H = (bf16*)(ws + WS_H); B.P = (bf16*)(ws + WS_P); B.ACT = (bf16*)(ws + WS_ACT);
    B.OF = (bf16*)(ws + WS_OFB); B.OB = B.OF + (size_t)M * HGW;
    B.S5Y = (bf16*)(ws + WS_S5Y); B.Y = (bf16*)(ws + WS_Y); B.S5M = (bf16*)(ws + WS_S5M); B.A16 = B.BB + DEPTH * 2 * S5G * S5P * S5H * 2;
    for (int u = threadIdx.x; u < (HALO_OFF - LDSCTL_OFF) / 4; u += NT) ((LAS unsigned*)(lds + LDSCTL_OFF))[u] = 0u;
    __syncthreads();
    XcdBarrier bar = xcd_barrier_post((unsigned*)(ws + WS_CTL) + CW_BAR, MISC + 8);
#define GRID_BAR() xcd_barrier(bar)

    for (int rep = 0; rep < REP_A; ++rep) {
    p_mod(args, B, lds, vcu, G);
    p_small(args, B, vcu, G);
    p_wprep(args, B, lds, vcu, G);
    p_s5mats(args, B.S5M, B.A16, lds, vcu, G);
    GRID_BAR(); }
    p_modulate(args, B, B.MOD, 0, D, vcu, G);
    GRID_BAR();
    float* const DUM1 = (float*)(ws + WS_P);
    float* const DUM2 = (float*)(ws + WS_OFB);
    for (int l = 0; l < DEPTH; ++l) {
        const float* modl = B.MOD + (size_t)l * 5 * 6 * D;
        for (int rep = 0; rep < REP_B; ++rep) {
        { pg8::Gemm g{B.H, B.WIN + (size_t)l * INC * D, M, INC, D}; pg8::StaticOrder S; S.init(M, INC, G, bx); pg8::EpiBf16Plain E{B.P, INC};
          pg8::gemm_phase<pg8::EpiBf16Plain, pg8::StaticOrder, true, true>(lds, g, S, E); }
        GRID_BAR(); }
        for (int rep = 0; rep < REP_C; ++rep) {
        if (vcu < 128) p_s5(args, B, B.S5M, B.A16, l, lds, vcu, 128); else p_gla_sum(args, B, (float*)B.Y, l, lds, vcu - 128, G - 128);
        GRID_BAR(); }
        for (int rep = 0; rep < REP_D; ++rep) {
        p_gla_out(args, B, (const float*)B.Y, l, lds, vcu, G);
        GRID_BAR(); }
        for (int rep = 0; rep < REP_F; ++rep) {
        if (bx < 136) { pg8::Gemm g{B.S5Y, B.WGLU + (size_t)l * S5W * S5W, M, S5W, S5W}; pg8::StaticOrder S; S.init(M, S5W, 136, bx); pg8::EpiGlu E{B.Y, B.S5Y, args.in[I_BGLU] + (size_t)l * S5W};
          pg8::gemm_phase<pg8::EpiGlu, pg8::StaticOrder, true, true>(lds, g, S, E); }
        else p_mixout(args, B, l, (bx - 136) * 8 + (TIDX >> 6), (G - 136) * 8);
        GRID_BAR(); }
        for (int rep = 0; rep < REP_G; ++rep) {
        { pg8::Gemm g{B.Y, B.WOUT + (size_t)l * D * D, M, D, D}; pg8::StaticOrder S; S.init(M, D, G, bx); pg8::EpiResid E{rep ? DUM1 : B.XC, rep ? DUM1 + (size_t)MC * D : args.out, modl, 2 * D};
          pg8::gemm_phase<pg8::EpiResid, pg8::StaticOrder, true, true>(lds, g, S, E); }
        GRID_BAR(); }
        for (int rep = 0; rep < REP_H; ++rep) {
        p_ln(rep ? DUM1 : B.XC, rep ? DUM1 + (size_t)MC * D : args.out, rep ? (bf16*)DUM2 : B.H, args.in[I_LN1G] + (size_t)l * D, args.in[I_LN1B] + (size_t)l * D, modl, 3 * D, 4 * D, vcu, G);
        GRID_BAR(); }
        for (int rep = 0; rep < REP_I; ++rep) {
        { pg8::Gemm g{B.H, B.WUP + (size_t)l * 2 * DFF * D, M, 2 * DFF, D}; pg8::StaticOrder S; S.init(M, 2 * DFF, G, bx);
          pg8::EpiUpConv E{B.ACT, args.in[I_CONVW] + (size_t)l * 3 * 2 * DFF, args.in[I_CONVB] + (size_t)l * 2 * DFF, (LAS float*)(lds + HALO_OFF)};
          pg8::gemm_phase<pg8::EpiUpConv, pg8::StaticOrder, true, true>(lds, g, S, E); }
        GRID_BAR(); }
        for (int rep = 0; rep < REP_J; ++rep) {
        { pg8::Gemm g{B.ACT, B.WDN + (size_t)l * D * DFF, M, D, DFF}; pg8::StaticOrder S; S.init(M, D, G, bx); pg8::EpiResid E{rep ? DUM2 : B.XC, rep ? DUM2 + (size_t)MC * D : args.out, modl, 5 * D};
          pg8::gemm_phase<pg8::EpiResid, pg8::StaticOrder, true, true>(lds, g, S, E); }
        GRID_BAR(); }
        p_ln(B.XC, args.out, B.H, args.in[I_LN2G] + (size_t)l * D, args.in[I_LN2B] + (size_t)l * D, l + 1 < DEPTH ? modl + 5 * 6 * D : nullptr, 0, D, vcu, G);
        if (l + 1 < DEPTH) GRID_BAR();
    }
}

#undef TIDX
extern "C" void kernel_launch(void* const* d_in, const int* in_sizes, int n_in, void* d_out, int out_size, void* d_ws, size_t ws_size, hipStream_t stream) {
    static int grid = 0;
    if (grid == 0) {
        if (n_in != N_IN || out_size != MX * D || ws_size < WS_END) { fprintf(stderr, "kernel_launch: unexpected shapes (n_in %d out %d ws %zu)\n", n_in, out_size, ws_size); grid = -1; return; }
        int dev = 0, cus = 0, per_cu = 0;
        if (hipGetDevice(&dev) != hipSuccess || hipDeviceGetAttribute(&cus, hipDeviceAttributeMultiprocessorCount, dev) != hipSuccess) { grid = -1; return; }
        if (hipFuncSetAttribute((const void*)mk_fwd, hipFuncAttributeMaxDynamicSharedMemorySize, LDS_BYTES) != hipSuccess) { fprintf(stderr, "kernel_launch: hipFuncSetAttribute failed\n"); grid = -1; return; }
        if (hipOccupancyMaxActiveBlocksPerMultiprocessor(&per_cu, (const void*)mk_fwd, NT, LDS_BYTES) != hipSuccess || per_cu < 1) { fprintf(stderr, "kernel_launch: occupancy query says %d blocks/CU\n", per_cu); per_cu = 1; }
        (void)hipGetLastError();
        grid = cus;
    }
    if (grid < 0) return;
    if (hipMemsetAsync((char*)d_ws + WS_CTL, 0, CTL_ZERO_BYTES, stream) != hipSuccess) return;
    Args a{};
    for (int i = 0; i < N_IN; ++i) a.in[i] = (const float*)d_in[i];
    a.out = (float*)d_out; a.ws = (unsigned char*)d_ws;
    hipLaunchKernelGGL(mk_fwd, dim3(grid), dim3(NT), LDS_BYTES, stream, a);
}
```
